# Optimizing an MI355X kernel written in HIP

```python
import math
import jax
import jax.numpy as jnp
from jax import lax
import numpy as np

D_MODEL = 1024
BATCH = 16
SEQ = 2048
DEPTH = 1
DEC_BATCH = 4
DEC_SEQ = 4096
PAST_LEN = 128

D_FF = 2816
CHUNK = 128
A_WIDTH = 512
A_GROUPS = 8
A_GROUP_DIM = A_WIDTH // A_GROUPS
B_HEADS = 4
HEAD_DIM = 64
B_QK = B_HEADS * 2 * HEAD_DIM
B_V = B_HEADS * 2 * HEAD_DIM
Q_BLOCK = 128
N_BUCKETS = 32
MAX_DISTANCE = 128
IN_COLS = 2 * A_WIDTH + 2 * B_QK + B_V + 2 * D_MODEL
EPS = 1e-6

kernel_name = "hybrid_sgu_diffattn_macaron_encoder"


def rms_norm(x, g):
    xf = x.astype(jnp.float32)
    y = xf * lax.rsqrt(jnp.mean(xf * xf, axis=-1, keepdims=True) + EPS)
    return (y * g.astype(jnp.float32)).astype(x.dtype)


def swiglu_ffn(x, w_in, w_out):
    gate, up = jnp.split(x @ w_in, 2, axis=-1)
    return (jax.nn.silu(gate) * up) @ w_out


def rel_position_bucket(rel):
    half = N_BUCKETS // 2
    max_exact = half // 2
    bucket = jnp.where(rel > 0, half, 0).astype(jnp.int32)
    n = jnp.abs(rel)
    nf = jnp.maximum(n, 1).astype(jnp.float32)
    large = max_exact + (jnp.log(nf / max_exact) / math.log(MAX_DISTANCE / max_exact)
                         * (half - max_exact)).astype(jnp.int32)
    large = jnp.minimum(large, half - 1)
    return bucket + jnp.where(n < max_exact, n, large)


def spatial_gating(u, v, norm_g, w_s, b_s):
    B, S, _ = v.shape
    vc = rms_norm(v, norm_g).reshape(B, S // CHUNK, CHUNK, A_GROUPS, A_GROUP_DIM)
    s = jnp.einsum('gts,bcsgd->bctgd', w_s, vc) + b_s.T[None, None, :, :, None]
    return u * s.reshape(B, S, A_WIDTH)


def diff_attention(q, k, v, lam, rel_bias):
    B, S, H, _, dh = q.shape
    nq = S // Q_BLOCK
    qb = jnp.moveaxis(q.reshape(B, nq, Q_BLOCK, H, 2, dh), 1, 0)
    kpos = jnp.arange(S, dtype=jnp.int32)

    def one_block(args):
        qblk, start = args
        logits = jnp.einsum('bqhcd,bkhcd->bhcqk', qblk, k,
                            preferred_element_type=jnp.float32)
        qpos = start + jnp.arange(Q_BLOCK, dtype=jnp.int32)
        bias = rel_bias[rel_position_bucket(kpos[None, :] - qpos[:, None])].astype(jnp.float32)
        logits = logits + jnp.transpose(bias, (2, 0, 1))[None, :, None]
        p = jax.nn.softmax(logits, axis=-1)
        w = p[:, :, 0] - lam * p[:, :, 1]
        return jnp.einsum('bhqk,bkhe->bqhe', w.astype(v.dtype), v)

    starts = jnp.arange(nq, dtype=jnp.int32) * Q_BLOCK
    out = lax.map(one_block, (qb, starts))
    return jnp.moveaxis(out, 0, 1).reshape(B, S, H, 2 * dh)


def encoder_layer(x, layer_idx, rel_bias, ffn1_norm, ffn1_w_in, ffn1_w_out, mix_norm, w_in,
                  gate_bias, sgu_norm, sgu_w, sgu_b, q_norm, k_norm, lambda_q1, lambda_k1,
                  lambda_q2, lambda_k2, diff_subln, w_proj_a, w_proj_b, w_out,
                  ffn2_norm, ffn2_w_in, ffn2_w_out, final_norm):
    B, S, _ = x.shape
    x = x + 0.5 * swiglu_ffn(rms_norm(x, ffn1_norm), ffn1_w_in, ffn1_w_out)

    h = rms_norm(x, mix_norm)
    proj = h @ w_in
    c0 = 2 * A_WIDTH
    c1 = c0 + B_QK
    c2 = c1 + B_QK
    c3 = c2 + B_V
    uv, q, k, v, g = jnp.split(proj, [c0, c1, c2, c3], axis=-1)

    u, va = jnp.split(jax.nn.gelu(uv), 2, axis=-1)
    a_out = spatial_gating(u, va, sgu_norm, sgu_w, sgu_b)

    q = rms_norm(q.reshape(B, S, B_HEADS, 2, HEAD_DIM), q_norm) * (HEAD_DIM ** -0.5)
    k = rms_norm(k.reshape(B, S, B_HEADS, 2, HEAD_DIM), k_norm)
    v = v.reshape(B, S, B_HEADS, 2 * HEAD_DIM)
    lambda_init = 0.8 - 0.6 * math.exp(-0.3 * layer_idx)
    lam = (jnp.exp(jnp.sum(lambda_q1.astype(jnp.float32) * lambda_k1.astype(jnp.float32)))
           - jnp.exp(jnp.sum(lambda_q2.astype(jnp.float32) * lambda_k2.astype(jnp.float32)))
           + lambda_init)
    b_out = diff_attention(q, k, v, lam, rel_bias)
    b_out = (rms_norm(b_out, diff_subln) * (1.0 - lambda_init)).reshape(B, S, B_V)

    gates = jax.nn.sigmoid((g + gate_bias).astype(jnp.float32)).astype(x.dtype)
    g_a, g_b = jnp.split(gates, 2, axis=-1)
    merged = g_a * (a_out @ w_proj_a) + g_b * (b_out @ w_proj_b)
    x = x + merged @ w_out

    x = x + 0.5 * swiglu_ffn(rms_norm(x, ffn2_norm), ffn2_w_in, ffn2_w_out)
    return rms_norm(x, final_norm)


def setup_inputs(seed: int = 0) -> dict:
    key = jax.random.key(seed)
    ks = iter(jax.random.split(key, 40))
    nrm = lambda shape, s: jax.random.normal(next(ks), shape, jnp.float32) * s
    gain = lambda shape: 1.0 + nrm(shape, 0.01)
    L = DEPTH
    return {
        "x_prompt": nrm((BATCH, SEQ, D_MODEL), 1.0),
        "x_sample": nrm((DEC_BATCH, DEC_SEQ, D_MODEL), 1.0),
        "rel_bias": nrm((N_BUCKETS, B_HEADS), 0.5),
        "ffn1_norm": gain((L, D_MODEL)),
        "ffn1_w_in": nrm((L, D_MODEL, 2 * D_FF), D_MODEL ** -0.5),
        "ffn1_w_out": nrm((L, D_FF, D_MODEL), D_FF ** -0.5),
        "mix_norm": gain((L, D_MODEL)),
        "w_in": nrm((L, D_MODEL, IN_COLS), D_MODEL ** -0.5),
        "gate_bias": nrm((L, 2 * D_MODEL), 0.02),
        "sgu_norm": gain((L, A_WIDTH)),
        "sgu_w": nrm((L, A_GROUPS, CHUNK, CHUNK), CHUNK ** -0.5),
        "sgu_b": 1.0 + nrm((L, A_GROUPS, CHUNK), 0.02),
        "q_norm": gain((L, HEAD_DIM)),
        "k_norm": gain((L, HEAD_DIM)),
        "lambda_q1": nrm((L, HEAD_DIM), 0.1),
        "lambda_k1": nrm((L, HEAD_DIM), 0.1),
        "lambda_q2": nrm((L, HEAD_DIM), 0.1),
        "lambda_k2": nrm((L, HEAD_DIM), 0.1),
        "diff_subln": gain((L, 2 * HEAD_DIM)),
        "w_proj_a": nrm((L, A_WIDTH, D_MODEL), A_WIDTH ** -0.5),
        "w_proj_b": nrm((L, B_V, D_MODEL), B_V ** -0.5),
        "w_out": nrm((L, D_MODEL, D_MODEL), D_MODEL ** -0.5),
        "ffn2_norm": gain((L, D_MODEL)),
        "ffn2_w_in": nrm((L, D_MODEL, 2 * D_FF), D_MODEL ** -0.5),
        "ffn2_w_out": nrm((L, D_FF, D_MODEL), D_FF ** -0.5),
        "final_norm": gain((L, D_MODEL)),
    }


def reference(x_prompt, x_sample, rel_bias, ffn1_norm, ffn1_w_in, ffn1_w_out, mix_norm, w_in,
              gate_bias, sgu_norm, sgu_w, sgu_b, q_norm, k_norm, lambda_q1, lambda_k1,
              lambda_q2, lambda_k2, diff_subln, w_proj_a, w_proj_b, w_out,
              ffn2_norm, ffn2_w_in, ffn2_w_out, final_norm):
    y_prompt = x_prompt
    y_sample = x_sample
    for l in range(DEPTH):
        layer_params = (ffn1_norm[l], ffn1_w_in[l], ffn1_w_out[l], mix_norm[l], w_in[l],
                        gate_bias[l], sgu_norm[l], sgu_w[l], sgu_b[l], q_norm[l], k_norm[l],
                        lambda_q1[l], lambda_k1[l], lambda_q2[l], lambda_k2[l], diff_subln[l],
                        w_proj_a[l], w_proj_b[l], w_out[l], ffn2_norm[l], ffn2_w_in[l],
                        ffn2_w_out[l], final_norm[l])
        y_prompt = encoder_layer(y_prompt, l, rel_bias, *layer_params)
        y_sample = encoder_layer(y_sample, l, rel_bias, *layer_params)
    return (y_prompt, y_sample)
```

```cpp
#include <hip/hip_runtime.h>
#include <hip/hip_cooperative_groups.h>
#include <cstdio>
#include <cstdint>
namespace cg = cooperative_groups;

#define LAS __attribute__((address_space(3)))
typedef unsigned short bf16_t;
typedef short bf16x8 __attribute__((ext_vector_type(8)));
typedef short s16x4 __attribute__((ext_vector_type(4)));
typedef float f32x4 __attribute__((ext_vector_type(4)));
typedef float f32x2 __attribute__((ext_vector_type(2)));
typedef unsigned u32x4 __attribute__((ext_vector_type(4)));
typedef unsigned u32x2 __attribute__((ext_vector_type(2)));
typedef __bf16 bf16x2_t __attribute__((ext_vector_type(2)));

constexpr int DM = 1024, DFF = 2816, MP = 32768, MS = 16384, MT = MP + MS;
constexpr int NSEQ_P = 16, SEQ_P = 2048, NSEQ_S = 4, SEQ_S = 4096;
constexpr int NA1 = 2560, NG = 2048, NIN = NA1 + NG;
constexpr float EPS = 1e-6f;
constexpr float LOG2E = 1.4426950408889634f;
constexpr float QSCALE = 0.125f * LOG2E;

constexpr size_t MiB = 1u << 20;
constexpr size_t WS_STA = 0, WS_STV = 3 * MiB;
constexpr size_t WS_W1IN = 6 * MiB;
constexpr size_t WS_W1OUT = WS_W1IN + (size_t)5632 * 1024 * 2;
constexpr size_t WS_WIN = WS_W1OUT + (size_t)1024 * 2816 * 2;
constexpr size_t WS_WP = WS_WIN + (size_t)4608 * 1024 * 2;
constexpr size_t WS_WO = WS_WP + (size_t)1024 * 1024 * 2;
constexpr size_t WS_W2IN = WS_WO + (size_t)1024 * 1024 * 2;
constexpr size_t WS_W2OUT = WS_W2IN + (size_t)5632 * 1024 * 2;
constexpr size_t WS_SGUW = WS_W2OUT + (size_t)1024 * 2816 * 2;
constexpr size_t WS_R = 53 * MiB;
static_assert(WS_SGUW + 8 * 128 * 128 * 2 <= WS_R, "weights fit");
constexpr size_t WS_XB = WS_R;
constexpr size_t WS_MG = WS_R;
constexpr size_t WS_UQ = WS_R + 96 * MiB;
constexpr size_t WS_XB2 = WS_UQ;
constexpr size_t WS_VA = WS_R + 192 * MiB;
constexpr size_t WS_KB = WS_R + 240 * MiB;
constexpr size_t WS_VB = WS_R + 288 * MiB;
constexpr size_t WS_GA = WS_R + 192 * MiB;
constexpr size_t WS_GB = WS_R + 288 * MiB;
constexpr size_t WS_ACT = WS_R + 192 * MiB;
constexpr size_t WS_END = WS_ACT + (size_t)MT * DFF * 2;
static_assert(WS_END <= 512 * MiB, "workspace");

constexpr int LDS_BYTES = 147456;

__device__ __forceinline__ unsigned cvtpk(float lo, float hi) { f32x2 v = {lo, hi}; bf16x2_t b = __builtin_convertvector(v, bf16x2_t); return __builtin_bit_cast(unsigned, b); }
__device__ __forceinline__ float bflo(unsigned w) { return __uint_as_float(w << 16); }
__device__ __forceinline__ float bfhi(unsigned w) { return __uint_as_float(w & 0xffff0000u); }
__device__ __forceinline__ float fast_rcp(float x) { return __builtin_amdgcn_rcpf(x); }
__device__ __forceinline__ float fast_exp2(float x) { return __builtin_amdgcn_exp2f(x); }
__device__ __forceinline__ float sigmoidf_(float x) { return fast_rcp(1.0f + fast_exp2(-LOG2E * x)); }
__device__ __forceinline__ float siluf_(float x) { return x * sigmoidf_(x); }
__device__ __forceinline__ float gelu_tanh(float x) { const float z = x + 0.044715f * x * x * x; return x * fast_rcp(1.0f + fast_exp2((-2.0f * 0.7978845608028654f * LOG2E) * z)); }
__device__ __forceinline__ float wave_sum(float v) {
#pragma unroll
    for (int o = 1; o < 64; o <<= 1) v += __shfl_xor(v, o);
    return v;
}
__device__ __forceinline__ float rstd_from(const float* st, int row, int np, float inv_dim) {
    float s = 0.f;
    if (np == 1) s = st[(size_t)row * 16];
    else { const f32x4* p = (const f32x4*)(st + (size_t)row * 16);
#pragma unroll 4
        for (int i = 0; i < np / 4; ++i) { const f32x4 v = p[i]; s += (v[0] + v[1]) + (v[2] + v[3]); } }
    return __builtin_amdgcn_rsqf(s * inv_dim + EPS);
}

namespace pg8 {
constexpr int BM = 256, BK = 64, HALF = 128, HTB = HALF * BK * 2, STAGE_BYTES = 8 * HTB, NXCD = 8, WGM = 8;
__host__ __device__ __forceinline__ int lds_byte(int r, int c) { const int st = (r >> 4) * 2 + (c >> 5), rr = r & 15, cc = c & 31, ob = rr * 64 + cc * 2; return st * 1024 + (ob ^ (((ob >> 9) & 1) << 5)); }
__host__ __device__ __forceinline__ void stage_rc(int b, int& R, int& C) { const int st = b / 1024, sb = b % 1024, swz = sb ^ (((sb >> 9) & 1) << 5); R = (st >> 1) * 16 + swz / 64; C = (st & 1) * 32 + (swz % 64) / 2; }
__host__ __device__ __forceinline__ int perm32(int rho) { const int n = rho >> 4, i = rho & 15; return 8 * (i >> 2) + 4 * n + (i & 3); }

struct Unit { int pm, pn; };
struct Gemm { const bf16_t* A; const bf16_t* Bt; int M, N, K; };

struct StaticOrder {
    int nM, nN, nwg, G, c;
    __device__ void init(int M, int N, int G_, int c_) { nM = M / BM; nN = N / BM; nwg = nM * nN; G = G_; c = c_; }
    __device__ bool next(int i, Unit& u) const {
        const long L = (long)i * G + c; if (L >= nwg) return false;
        int wgid = (int)L; { const int q = nwg / NXCD, r = nwg % NXCD, xcd = wgid % NXCD, off = wgid / NXCD; wgid = (xcd < r ? xcd * (q + 1) : r * (q + 1) + (xcd - r) * q) + off; }
        const int nig = WGM * nN, gid = wgid / nig, fm = gid * WGM, gsz = (nM - fm) < WGM ? (nM - fm) : WGM;
        u.pm = fm + ((wgid % nig) % gsz); u.pn = (wgid % nig) / gsz; return true;
    }
};

template <class Epi>
__device__ __forceinline__ void gemm_phase(LAS unsigned char* lds, const Gemm g, const StaticOrder& S, const Epi& E) {
    const int tid = threadIdx.x, wid = __builtin_amdgcn_readfirstlane(tid >> 6), lane = tid & 63, wr = wid >> 2, wc = wid & 3, fr = lane & 15, fq = lane >> 4;
    const int K = g.K, nt = K / BK;
    unsigned voffA[2], voffB[2];
#pragma unroll
    for (int i = 0; i < 2; ++i) { int R, C; stage_rc(tid * 16 + i * 8192, R, C); const int Rb = (R & ~31) + perm32(R & 31);
        voffA[i] = (unsigned)(R * K + C) * 2u; voffB[i] = (unsigned)(Rb * K + C) * 2u; }
    const size_t kstep = (size_t)(BK * 2);
    const size_t hstep = (size_t)HALF * K * 2;
    const size_t tstep = 2 * hstep;
    const unsigned ldsw = (unsigned)wid * 1024u;
    const int aoff = lds_byte(wr * 64 + fr, fq * 8), boff = lds_byte(wc * 32 + fr, fq * 8);
#define PG8_SA(b, h) (((b) * 2 + (h)) * HTB)
#define PG8_SB(b, h) ((4 + (b) * 2 + (h)) * HTB)
#define PG8_STAGE(bufoff, gbase, voff) do { _Pragma("unroll") for (int _i = 0; _i < 2; ++_i) \
        __builtin_amdgcn_global_load_lds((const unsigned*)((const char*)(gbase) + (voff)[_i]), (LAS unsigned*)(lds + (bufoff) + ldsw + _i * 8192), 16, 0, 0); } while (0)
#define PG8_LDA(dst, b, h) do { _Pragma("unroll") for (int m = 0; m < 4; ++m) _Pragma("unroll") for (int k = 0; k < 2; ++k) dst[m][k] = *(const LAS bf16x8*)(lds + PG8_SA(b, h) + aoff + m * 2048 + k * 1024); } while (0)
#define PG8_LDB(dst, b, h) do { _Pragma("unroll") for (int n = 0; n < 2; ++n) _Pragma("unroll") for (int k = 0; k < 2; ++k) dst[n][k] = *(const LAS bf16x8*)(lds + PG8_SB(b, h) + boff + n * 2048 + k * 1024); } while (0)
#define PG8_MMA(ai, bj, At, Bt) do { __builtin_amdgcn_s_setprio(1); _Pragma("unroll") for (int m = 0; m < 4; ++m) _Pragma("unroll") for (int n = 0; n < 2; ++n) _Pragma("unroll") for (int k = 0; k < 2; ++k) \
        acc[ai][bj][m][n] = __builtin_amdgcn_mfma_f32_16x16x32_bf16(Bt[n][k], At[m][k], acc[ai][bj][m][n], 0, 0, 0); __builtin_amdgcn_s_setprio(0); } while (0)
#define PG8_WAIT_V(n) asm volatile("s_waitcnt vmcnt(" #n ")" ::: "memory")
#define PG8_WAIT_L(n) asm volatile("s_waitcnt lgkmcnt(" #n ")" ::: "memory")
#define PG8_BAR __builtin_amdgcn_s_barrier()
#define PG8_SCHED __builtin_amdgcn_sched_barrier(0)
    Unit cur, nxt; int ui = 0;
    if (!S.next(0, cur)) return;
    f32x4 acc[2][2][4][2];
#pragma unroll
    for (int a = 0; a < 2; ++a)
#pragma unroll
        for (int b = 0; b < 2; ++b)
#pragma unroll
            for (int m = 0; m < 4; ++m)
#pragma unroll
                for (int n = 0; n < 2; ++n) acc[a][b][m][n] = (f32x4){0.f, 0.f, 0.f, 0.f};
    bf16x8 At[4][2], B0[2][2], B1[2][2];
    const char* cA = (const char*)g.A + (size_t)cur.pm * tstep; const char* cB = (const char*)g.Bt + (size_t)cur.pn * tstep;
    PG8_STAGE(PG8_SB(0, 0), cB, voffB); PG8_STAGE(PG8_SB(0, 1), cB + hstep, voffB); PG8_STAGE(PG8_SA(0, 0), cA, voffA); PG8_STAGE(PG8_SA(0, 1), cA + hstep, voffA);
    if (wr == 1) PG8_BAR;
    PG8_WAIT_V(2); PG8_BAR;
    PG8_STAGE(PG8_SB(1, 0), cB + kstep, voffB); PG8_STAGE(PG8_SA(1, 0), cA + kstep, voffA); PG8_STAGE(PG8_SB(1, 1), cB + hstep + kstep, voffB);
    PG8_WAIT_V(6); PG8_BAR;
    for (;;) {
        const bool has_next = S.next(ui + 1, nxt);
        const char* nA = has_next ? (const char*)g.A + (size_t)nxt.pm * tstep : cA; const char* nB = has_next ? (const char*)g.Bt + (size_t)nxt.pn * tstep : cB;
        for (int t = 0; t < nt; t += 2) {
            const bool last = (t == nt - 2);
            const char* a1 = cA + (size_t)(t + 1) * kstep;
            const char* a2 = last ? nA : cA + (size_t)(t + 2) * kstep; const char* b2 = last ? nB : cB + (size_t)(t + 2) * kstep;
            const char* a3 = a2 + kstep; const char* b3 = b2 + kstep;
            if constexpr (Epi::MIDK > 0) { if (t == Epi::MIDK) E.mid(acc, cur, wr, wc, fr, fq); }
            PG8_LDB(B0, 0, 0); PG8_LDB(B1, 0, 1); PG8_SCHED; PG8_LDA(At, 0, 0); PG8_STAGE(PG8_SA(1, 1), a1 + hstep, voffA);
            PG8_WAIT_V(8); PG8_WAIT_L(0); PG8_BAR; PG8_MMA(0, 0, At, B0); PG8_MMA(0, 1, At, B1); PG8_BAR; PG8_SCHED;
            PG8_LDA(At, 0, 1); PG8_STAGE(PG8_SB(0, 0), b2, voffB); PG8_STAGE(PG8_SB(0, 1), b2 + hstep, voffB); PG8_STAGE(PG8_SA(0, 0), a2, voffA);
            PG8_WAIT_V(8); PG8_WAIT_L(0); PG8_BAR; PG8_MMA(1, 0, At, B0); PG8_MMA(1, 1, At, B1); PG8_BAR; PG8_SCHED;
            PG8_LDB(B0, 1, 0); PG8_LDB(B1, 1, 1); PG8_SCHED; PG8_LDA(At, 1, 0); PG8_STAGE(PG8_SA(0, 1), a2 + hstep, voffA);
            PG8_WAIT_V(8); PG8_WAIT_L(0); PG8_BAR; PG8_MMA(0, 0, At, B0); PG8_MMA(0, 1, At, B1); PG8_BAR; PG8_SCHED;
            PG8_LDA(At, 1, 1); PG8_STAGE(PG8_SB(1, 0), b3, voffB); PG8_STAGE(PG8_SB(1, 1), b3 + hstep, voffB); PG8_STAGE(PG8_SA(1, 0), a3, voffA);
            PG8_WAIT_V(8); PG8_WAIT_L(0); PG8_BAR; PG8_MMA(1, 0, At, B0); PG8_MMA(1, 1, At, B1); PG8_BAR; PG8_SCHED;
        }
        if (wr == 0) PG8_BAR;
        E(acc, cur, wr, wc, fr, fq);
        if (!has_next) break;
#pragma unroll
        for (int a = 0; a < 2; ++a)
#pragma unroll
            for (int b = 0; b < 2; ++b)
#pragma unroll
                for (int m = 0; m < 4; ++m)
#pragma unroll
                    for (int n = 0; n < 2; ++n) acc[a][b][m][n] = (f32x4){0.f, 0.f, 0.f, 0.f};
        cur = nxt; cA = nA; cB = nB; ++ui;
        if (wr == 1) PG8_BAR;
    }
    PG8_WAIT_V(0);
    PG8_BAR;
#undef PG8_SA
#undef PG8_SB
#undef PG8_STAGE
#undef PG8_LDA
#undef PG8_LDB
#undef PG8_MMA
#undef PG8_WAIT_V
#undef PG8_WAIT_L
#undef PG8_BAR
#undef PG8_SCHED
}
}
using pg8::Unit;
typedef f32x4 Acc[2][2][4][2];
#define FENCE() asm volatile("" ::: "memory")

struct EpiSwiGLU {
    static constexpr int MIDK = 0;
    bf16_t* O; const float* st; int np;
    __device__ __forceinline__ void mid(Acc&, const Unit&, int, int, int, int) const {}
    __device__ __forceinline__ void operator()(const Acc& acc, const Unit& u, int wr, int wc, int fr, int fq) const {
        const int col = u.pn * 128 + wc * 32 + fq * 8;
#pragma unroll
        for (int ai = 0; ai < 2; ++ai)
#pragma unroll
            for (int m = 0; m < 4; ++m) {
                const int r = u.pm * 256 + ai * 128 + wr * 64 + m * 16 + fr;
                const float rs = rstd_from(st, r, np, 1.0f / 1024.0f);
                float o[8];
#pragma unroll
                for (int n = 0; n < 2; ++n)
#pragma unroll
                    for (int e = 0; e < 4; ++e) { const float gv = acc[ai][0][m][n][e] * rs, uv = acc[ai][1][m][n][e] * rs; o[4 * n + e] = siluf_(gv) * uv; }
                u32x4 w; w.x = cvtpk(o[0], o[1]); w.y = cvtpk(o[2], o[3]); w.z = cvtpk(o[4], o[5]); w.w = cvtpk(o[6], o[7]);
                *(u32x4*)(O + (size_t)r * DFF + col) = w;
            }
    }
};

struct EpiRes {
    static constexpr int MIDK = 0;
    const float* baseA; const float* baseB; float* out; bf16_t* xb; float* st; float scale;
    __device__ __forceinline__ void mid(Acc&, const Unit&, int, int, int, int) const {}
    __device__ __forceinline__ void operator()(const Acc& acc, const Unit& u, int wr, int wc, int fr, int fq) const {
        const int col = u.pn * 256 + wc * 32 + fq * 8;
#pragma unroll
        for (int ai = 0; ai < 2; ++ai)
#pragma unroll
            for (int m = 0; m < 4; ++m) {
                const int r = u.pm * 256 + ai * 128 + wr * 64 + m * 16 + fr;
                const float* bp = (r < MP ? baseA : baseB) + (size_t)r * DM + col;
                float q = 0.f;
#pragma unroll
                for (int bj = 0; bj < 2; ++bj) {
                    const f32x4 b0 = *(const f32x4*)(bp + bj * 128), b1 = *(const f32x4*)(bp + bj * 128 + 4);
                    const f32x4 v0 = b0 + acc[ai][bj][m][0] * scale, v1 = b1 + acc[ai][bj][m][1] * scale;
                    float* op = out + (size_t)r * DM + col + bj * 128;
                    *(f32x4*)op = v0; *(f32x4*)(op + 4) = v1;
                    q += (v0[0] * v0[0] + v0[1] * v0[1]) + (v0[2] * v0[2] + v0[3] * v0[3]) + (v1[0] * v1[0] + v1[1] * v1[1]) + (v1[2] * v1[2] + v1[3] * v1[3]);
                    if (xb) { u32x4 w; w.x = cvtpk(v0[0], v0[1]); w.y = cvtpk(v0[2], v0[3]); w.z = cvtpk(v1[0], v1[1]); w.w = cvtpk(v1[2], v1[3]);
                        *(u32x4*)(xb + (size_t)r * DM + col + bj * 128) = w; }
                }
                q += __shfl_xor(q, 16); q += __shfl_xor(q, 32);
                if (fq == 0) st[(size_t)r * 16 + u.pn * 4 + wc] = q;
                if (m & 1) FENCE();
            }
    }
};

struct EpiMixA {
    static constexpr int MIDK = 0;
    bf16_t* UQ; bf16_t* VA; bf16_t* KB; bf16_t* VB; const float* st; float* stv; const float* qn; const float* kn;
    __device__ __forceinline__ void mid(Acc&, const Unit&, int, int, int, int) const {}
    __device__ __forceinline__ void operator()(const Acc& acc, const Unit& u, int wr, int wc, int fr, int fq) const {
        const int t = u.pn;
        if (t < 4 || t >= 8) {
            bf16_t* base; int pitch, c0; const bool act = t < 4;
            if (t < 2) { base = UQ; pitch = DM; c0 = 256 * t; } else if (t < 4) { base = VA; pitch = 512; c0 = 256 * (t - 2); } else { base = VB; pitch = 512; c0 = 256 * (t - 8); }
            const int col = c0 + wc * 32 + fq * 8;
#pragma unroll
            for (int ai = 0; ai < 2; ++ai)
#pragma unroll
                for (int m = 0; m < 4; ++m) {
                    const int r = u.pm * 256 + ai * 128 + wr * 64 + m * 16 + fr;
                    const float rs = rstd_from(st, r, 16, 1.0f / 1024.0f);
                    float q = 0.f;
#pragma unroll
                    for (int bj = 0; bj < 2; ++bj) {
                        float o[8];
#pragma unroll
                        for (int n = 0; n < 2; ++n)
#pragma unroll
                            for (int e = 0; e < 4; ++e) { float v = acc[ai][bj][m][n][e] * rs; if (act) v = gelu_tanh(v); o[4 * n + e] = v; q += v * v; }
                        u32x4 w; w.x = cvtpk(o[0], o[1]); w.y = cvtpk(o[2], o[3]); w.z = cvtpk(o[4], o[5]); w.w = cvtpk(o[6], o[7]);
                        *(u32x4*)(base + (size_t)r * pitch + col + bj * 128) = w;
                    }
                    if (t == 2 || t == 3) { q += __shfl_xor(q, 16); q += __shfl_xor(q, 32); if (fq == 0) stv[(size_t)r * 16 + (t - 2) * 4 + wc] = q; }
                }
        } else {
            const bool isq = t < 6;
            const float* gn = isq ? qn : kn; const float sc = isq ? QSCALE : 1.0f;
            f32x4 gv[2][2];
#pragma unroll
            for (int bj = 0; bj < 2; ++bj)
#pragma unroll
                for (int n = 0; n < 2; ++n) gv[bj][n] = *(const f32x4*)(gn + 32 * bj + 8 * fq + 4 * n) * sc;
            bf16_t* base = isq ? (UQ + 512 + 256 * (t - 4)) : (KB + 256 * (t - 6));
            const int pitch = isq ? DM : 512;
            const int col = wc * 64 + fq * 8;
#pragma unroll
            for (int ai = 0; ai < 2; ++ai)
#pragma unroll
                for (int m = 0; m < 4; ++m) {
                    const int r = u.pm * 256 + ai * 128 + wr * 64 + m * 16 + fr;
                    const float rs = rstd_from(st, r, 16, 1.0f / 1024.0f);
                    f32x4 v[2][2]; float q = 0.f;
#pragma unroll
                    for (int bj = 0; bj < 2; ++bj)
#pragma unroll
                        for (int n = 0; n < 2; ++n) { v[bj][n] = acc[ai][bj][m][n] * rs; const f32x4 x = v[bj][n]; q += (x[0] * x[0] + x[1] * x[1]) + (x[2] * x[2] + x[3] * x[3]); }
                    q += __shfl_xor(q, 16); q += __shfl_xor(q, 32);
                    const float rq = __builtin_amdgcn_rsqf(q * (1.0f / 64.0f) + EPS);
#pragma unroll
                    for (int bj = 0; bj < 2; ++bj) {
                        const f32x4 a = v[bj][0] * gv[bj][0] * rq, b = v[bj][1] * gv[bj][1] * rq;
                        u32x4 w; w.x = cvtpk(a[0], a[1]); w.y = cvtpk(a[2], a[3]); w.z = cvtpk(b[0], b[1]); w.w = cvtpk(b[2], b[3]);
                        *(u32x4*)(base + (size_t)r * pitch + col + bj * 32) = w;
                    }
                }
        }
    }
};

struct EpiGate {
    static constexpr int MIDK = 0;
    bf16_t* GA; bf16_t* GB; const float* st; const float* gbias;
    __device__ __forceinline__ void mid(Acc&, const Unit&, int, int, int, int) const {}
    __device__ __forceinline__ void operator()(const Acc& acc, const Unit& u, int wr, int wc, int fr, int fq) const {
        bf16_t* base = u.pn < 4 ? GA : GB; const int col = (u.pn & 3) * 256 + wc * 32 + fq * 8;
        const float* bp = gbias + u.pn * 256 + wc * 32 + fq * 8;
        f32x4 bv[2][2];
#pragma unroll
        for (int bj = 0; bj < 2; ++bj)
#pragma unroll
            for (int n = 0; n < 2; ++n) bv[bj][n] = *(const f32x4*)(bp + bj * 128 + 4 * n);
#pragma unroll
        for (int ai = 0; ai < 2; ++ai)
#pragma unroll
            for (int m = 0; m < 4; ++m) {
                const int r = u.pm * 256 + ai * 128 + wr * 64 + m * 16 + fr;
                const float rs = rstd_from(st, r, 16, 1.0f / 1024.0f);
#pragma unroll
                for (int bj = 0; bj < 2; ++bj) {
                    float o[8];
#pragma unroll
                    for (int n = 0; n < 2; ++n)
#pragma unroll
                        for (int e = 0; e < 4; ++e) o[4 * n + e] = sigmoidf_(acc[ai][bj][m][n][e] * rs + bv[bj][n][e]);
                    u32x4 w; w.x = cvtpk(o[0], o[1]); w.y = cvtpk(o[2], o[3]); w.z = cvtpk(o[4], o[5]); w.w = cvtpk(o[6], o[7]);
                    *(u32x4*)(base + (size_t)r * DM + col + bj * 128) = w;
                }
            }
    }
};

struct EpiMerge {
    static constexpr int MIDK = 8;
    const bf16_t* GA; const bf16_t* GB; bf16_t* MG;
    __device__ __forceinline__ void mid(Acc& acc, const Unit& u, int wr, int wc, int fr, int fq) const {
        int col = u.pn * 256 + wc * 32 + fq * 8, rb = u.pm * 256 + wr * 64 + fr;
        asm volatile("" : "+v"(col), "+v"(rb));
#pragma unroll
        for (int ai = 0; ai < 2; ++ai)
#pragma unroll
            for (int m = 0; m < 4; ++m) {
                const int r = rb + ai * 128 + m * 16;
#pragma unroll
                for (int bj = 0; bj < 2; ++bj) {
                    const u32x4 a = *(const u32x4*)(GA + (size_t)r * DM + col + bj * 128), b = *(const u32x4*)(GB + (size_t)r * DM + col + bj * 128);
                    f32x4 r0, r1;
                    r0[0] = bflo(a.x) * fast_rcp(bflo(b.x)); r0[1] = bfhi(a.x) * fast_rcp(bfhi(b.x)); r0[2] = bflo(a.y) * fast_rcp(bflo(b.y)); r0[3] = bfhi(a.y) * fast_rcp(bfhi(b.y));
                    r1[0] = bflo(a.z) * fast_rcp(bflo(b.z)); r1[1] = bfhi(a.z) * fast_rcp(bfhi(b.z)); r1[2] = bflo(a.w) * fast_rcp(bflo(b.w)); r1[3] = bfhi(a.w) * fast_rcp(bfhi(b.w));
                    acc[ai][bj][m][0] *= r0; acc[ai][bj][m][1] *= r1;
                }
                if (m & 1) FENCE();
            }
    }
    __device__ __forceinline__ void operator()(const Acc& acc, const Unit& u, int wr, int wc, int fr, int fq) const {
        const int col = u.pn * 256 + wc * 32 + fq * 8;
#pragma unroll
        for (int ai = 0; ai < 2; ++ai)
#pragma unroll
            for (int m = 0; m < 4; ++m) {
                const int r = u.pm * 256 + ai * 128 + wr * 64 + m * 16 + fr;
#pragma unroll
                for (int bj = 0; bj < 2; ++bj) {
                    const u32x4 b = *(const u32x4*)(GB + (size_t)r * DM + col + bj * 128);
                    const f32x4 v0 = acc[ai][bj][m][0], v1 = acc[ai][bj][m][1];
                    u32x4 w; w.x = cvtpk(v0[0] * bflo(b.x), v0[1] * bfhi(b.x)); w.y = cvtpk(v0[2] * bflo(b.y), v0[3] * bfhi(b.y));
                    w.z = cvtpk(v1[0] * bflo(b.z), v1[1] * bfhi(b.z)); w.w = cvtpk(v1[2] * bflo(b.w), v1[3] * bfhi(b.w));
                    *(u32x4*)(MG + (size_t)r * DM + col + bj * 128) = w;
                }
                if (m & 1) FENCE();
            }
    }
};

struct Params { const float* in[26]; float* out; unsigned char* ws; int ph_lo, ph_hi; };

__device__ __forceinline__ void transpose_item(const float* W, int ldw, int k0, int srccol0, const float* gain, bf16_t* dst, int dpitch, int drow0, int dk0, LAS float* scr, int lane) {
#pragma unroll 8
    for (int i = 0; i < 32; ++i) { const int kk = 2 * i + (lane >> 5); float v = W[(size_t)(k0 + kk) * ldw + srccol0 + (lane & 31)]; if (gain) v *= gain[k0 + kk]; scr[kk * 33 + (lane & 31)] = v; }
    asm volatile("s_waitcnt lgkmcnt(0)" ::: "memory");
    const int c = lane & 7;
#pragma unroll
    for (int j = 0; j < 4; ++j) { const int n = (lane >> 3) + 8 * j; const LAS float* s = scr + (8 * c) * 33 + n;
        u32x4 o; o.x = cvtpk(s[0 * 33], s[1 * 33]); o.y = cvtpk(s[2 * 33], s[3 * 33]); o.z = cvtpk(s[4 * 33], s[5 * 33]); o.w = cvtpk(s[6 * 33], s[7 * 33]);
        *(u32x4*)(dst + (size_t)(drow0 + n) * dpitch + dk0 + k0 + 8 * c) = o; }
    asm volatile("s_waitcnt lgkmcnt(0)" ::: "memory");
}
__device__ __forceinline__ int map_ffn_in(int n) { const int pn = n >> 8, p = n & 255; return p < 128 ? 128 * pn + p : DFF + 128 * pn + (p - 128); }
__device__ __forceinline__ int map_win(int n) { if (n < 1024 || n >= 2048) return n; const int pn = n >> 8, p = n & 255, bj = p >> 7, wc = (p & 127) >> 5, j = p & 31; return 256 * pn + 64 * wc + 32 * bj + j; }

__device__ __forceinline__ void prologue(const Params& P, LAS unsigned char* lds, int gw, int NGW, int wave, int lane) {
    unsigned char* ws = P.ws;
    LAS float* scr = (LAS float*)(lds + wave * 16384);
    constexpr int I_IN = 16 * 176, I_OUT = 44 * 32, I_WIN = 16 * 144, I_P = 8 * 32, I_O = 16 * 32;
    constexpr int NITEMS = 2 * I_IN + 2 * I_OUT + I_WIN + 2 * I_P + I_O;
    for (int it = gw; it < NITEMS; it += NGW) {
        int r = it;
        if (r < 2 * I_IN) { const int w = r / I_IN; r -= w * I_IN; const int kb = r / 176, nb = r % 176;
            transpose_item(P.in[w ? 23 : 4], 2 * DFF, 64 * kb, map_ffn_in(32 * nb), P.in[w ? 22 : 3], (bf16_t*)(ws + (w ? WS_W2IN : WS_W1IN)), 1024, 32 * nb, 0, scr, lane); continue; }
        r -= 2 * I_IN;
        if (r < 2 * I_OUT) { const int w = r / I_OUT; r -= w * I_OUT; const int kb = r / 32, nb = r % 32;
            transpose_item(P.in[w ? 24 : 5], DM, 64 * kb, 32 * nb, nullptr, (bf16_t*)(ws + (w ? WS_W2OUT : WS_W1OUT)), DFF, 32 * nb, 0, scr, lane); continue; }
        r -= 2 * I_OUT;
        if (r < I_WIN) { const int kb = r / 144, nb = r % 144;
            transpose_item(P.in[7], NIN, 64 * kb, map_win(32 * nb), P.in[6], (bf16_t*)(ws + WS_WIN), 1024, 32 * nb, 0, scr, lane); continue; }
        r -= I_WIN;
        if (r < 2 * I_P) { const int w = r / I_P; r -= w * I_P; const int kb = r / 32, nb = r % 32;
            transpose_item(P.in[w ? 20 : 19], DM, 64 * kb, 32 * nb, nullptr, (bf16_t*)(ws + WS_WP), 1024, 32 * nb, w ? 512 : 0, scr, lane); continue; }
        r -= 2 * I_P;
        { const int kb = r / 32, nb = r % 32; transpose_item(P.in[21], DM, 64 * kb, 32 * nb, nullptr, (bf16_t*)(ws + WS_WO), 1024, 32 * nb, 0, scr, lane); }
    }
    { bf16_t* d = (bf16_t*)(ws + WS_SGUW); const float* s = P.in[10];
      for (int i = gw * 64 + lane; i < 8 * 128 * 128; i += NGW * 64) { const int lo = i & 31, hi = i & ~31, f = lo >> 3, e = lo & 7; const int src = hi + (e < 4 ? 4 * f + e : 16 + 4 * f + e - 4);
          const unsigned w = cvtpk(s[src], 0.f); d[i] = (bf16_t)(w & 0xffffu); } }
    { bf16_t* xb = (bf16_t*)(ws + WS_XB); float* st = (float*)(ws + WS_STA);
      for (int m = gw; m < MT; m += NGW) {
          const float* xr = (m < MP ? P.in[0] + (size_t)m * DM : P.in[1] + (size_t)(m - MP) * DM);
          const f32x4* x4 = (const f32x4*)xr + lane; f32x4 v[4]; float s = 0.f;
#pragma unroll
          for (int j = 0; j < 4; ++j) { v[j] = x4[64 * j]; s += (v[j][0] * v[j][0] + v[j][1] * v[j][1]) + (v[j][2] * v[j][2] + v[j][3] * v[j][3]); }
          s = wave_sum(s);
          u32x2* o = (u32x2*)(xb + (size_t)m * DM) + lane;
#pragma unroll
          for (int j = 0; j < 4; ++j) { u32x2 w; w.x = cvtpk(v[j][0], v[j][1]); w.y = cvtpk(v[j][2], v[j][3]); o[64 * j] = w; }
          if (lane == 0) st[(size_t)m * 16] = s;
      } }
}

constexpr int AT_KP = 272, AT_VP = 288;
constexpr int AT_KB = 64 * AT_KP, AT_VB = 64 * AT_VP;
constexpr int AT_K0 = 0, AT_V0 = 2 * AT_KB, AT_TAB = AT_V0 + 2 * AT_VB;
static_assert(AT_TAB + 260 * 4 <= 131072, "attention LDS");

__device__ __forceinline__ s16x4 tr_read(const LAS unsigned char* p) { return __builtin_bit_cast(s16x4, __builtin_amdgcn_ds_read_tr16_b64_v4i16((LAS s16x4*)p)); }

__device__ __forceinline__ int t5_bucket(int rel) {
    int b = rel > 0 ? 16 : 0; const int n = rel < 0 ? -rel : rel;
    if (n < 8) return b + n;
    const float nf = (float)n;
    int large = 8 + (int)(logf(nf / 8.0f) / 2.772588722239781f * 8.0f);
    large = large < 15 ? large : 15;
    return b + large;
}

__device__ __forceinline__ void attn_unit(LAS unsigned char* lds, int seq, int h, int qb, bf16_t* UQ, const bf16_t* KB, const bf16_t* VB, const float* rel_bias, const float* subln, float lam, float bmax) {
    const int tid = threadIdx.x, lane = tid & 63, w = __builtin_amdgcn_readfirstlane(tid >> 6), r16 = lane & 15, fq = lane >> 4;
    int row0, S; if (seq < NSEQ_P) { row0 = seq * SEQ_P; S = SEQ_P; } else { row0 = MP + (seq - NSEQ_P) * SEQ_S; S = SEQ_S; }
    const int q0 = qb * 128, NT = S / 64;
    LAS float* tab = (LAS float*)(lds + AT_TAB);
    if (tid < 257) tab[tid] = LOG2E * (rel_bias[t5_bucket(tid - 128) * 4 + h] - bmax);
    bf16x8 qf[2][2];
    { const bf16_t* qp = UQ + (size_t)(row0 + q0 + 16 * w + r16) * DM + 512 + 128 * h + 8 * fq;
#pragma unroll
      for (int c = 0; c < 2; ++c)
#pragma unroll
          for (int kk = 0; kk < 2; ++kk) qf[c][kk] = *(const bf16x8*)(qp + 64 * c + 32 * kk); }
    f32x4 o[2][8];
#pragma unroll
    for (int c = 0; c < 2; ++c)
#pragma unroll
        for (int d = 0; d < 8; ++d) o[c][d] = (f32x4){0.f, 0.f, 0.f, 0.f};
    float l0 = 0.f, l1 = 0.f;
    const int skey = tid >> 4, sch = tid & 15;
    const bf16_t* kg = KB + (size_t)(row0 + skey) * 512 + 128 * h + 8 * sch;
    const bf16_t* vg = VB + (size_t)(row0 + skey) * 512 + 128 * h + 8 * sch;
    const int kdst = skey * AT_KP + sch * 16, vdst = skey * AT_VP + sch * 16;
    u32x4 kr[2], vr[2];
#pragma unroll
    for (int i = 0; i < 2; ++i) { kr[i] = *(const u32x4*)(kg + (size_t)i * 32 * 512); vr[i] = *(const u32x4*)(vg + (size_t)i * 32 * 512); }
#pragma unroll
    for (int i = 0; i < 2; ++i) { *(LAS u32x4*)(lds + AT_K0 + kdst + i * 32 * AT_KP) = kr[i]; *(LAS u32x4*)(lds + AT_V0 + vdst + i * 32 * AT_VP) = vr[i]; }
    __syncthreads();
    const int qrow = q0 + 16 * w;
    const int kfo = r16 * AT_KP + fq * 16;
    const int vfo = (4 * fq + (r16 >> 2)) * AT_VP + (r16 & 3) * 8;
    for (int t = 0; t < NT; ++t) {
        const int buf = t & 1, k0 = t * 64;
        if (t + 1 < NT) {
#pragma unroll
            for (int i = 0; i < 2; ++i) { kr[i] = *(const u32x4*)(kg + (size_t)((t + 1) * 64 + i * 32) * 512); vr[i] = *(const u32x4*)(vg + (size_t)((t + 1) * 64 + i * 32) * 512); }
        }
        const LAS unsigned char* Kb = lds + AT_K0 + buf * AT_KB + kfo;
        const LAS unsigned char* Vb = lds + AT_V0 + buf * AT_VB + vfo;
        f32x4 s[2][4];
#pragma unroll
        for (int kt = 0; kt < 4; ++kt)
#pragma unroll
            for (int c = 0; c < 2; ++c) {
                f32x4 a = (f32x4){0.f, 0.f, 0.f, 0.f};
#pragma unroll
                for (int kk = 0; kk < 2; ++kk) { const bf16x8 kf = *(const LAS bf16x8*)(Kb + kt * 16 * AT_KP + (64 * c + 32 * kk) * 2); a = __builtin_amdgcn_mfma_f32_16x16x32_bf16(kf, qf[c][kk], a, 0, 0, 0); }
                s[c][kt] = a;
            }
        const int relmax = k0 + 63 - qrow, relmin = k0 - (qrow + 15);
        if (relmax <= -128 || relmin >= 128) {
            const float tb = relmin >= 128 ? tab[256] : tab[0];
#pragma unroll
            for (int kt = 0; kt < 4; ++kt)
#pragma unroll
                for (int j = 0; j < 4; ++j) { s[0][kt][j] += tb; s[1][kt][j] += tb; }
        } else {
            const int rb = k0 + 4 * fq - (qrow + r16) + 128;
#pragma unroll
            for (int kt = 0; kt < 4; ++kt)
#pragma unroll
                for (int j = 0; j < 4; ++j) { int idx = rb + 16 * kt + j; idx = idx < 0 ? 0 : (idx > 256 ? 256 : idx); const float tb = tab[idx]; s[0][kt][j] += tb; s[1][kt][j] += tb; }
        }
        bf16x8 pf[2][2];
#pragma unroll
        for (int c = 0; c < 2; ++c) {
            float ls = 0.f;
#pragma unroll
            for (int kt = 0; kt < 4; ++kt)
#pragma unroll
                for (int j = 0; j < 4; ++j) { const float p = fast_exp2(s[c][kt][j]); s[c][kt][j] = p; ls += p; }
            if (c == 0) l0 += ls; else l1 += ls;
#pragma unroll
            for (int si = 0; si < 2; ++si) {
                u32x4 wv; wv.x = cvtpk(s[c][2 * si][0], s[c][2 * si][1]); wv.y = cvtpk(s[c][2 * si][2], s[c][2 * si][3]);
                wv.z = cvtpk(s[c][2 * si + 1][0], s[c][2 * si + 1][1]); wv.w = cvtpk(s[c][2 * si + 1][2], s[c][2 * si + 1][3]);
                pf[c][si] = __builtin_bit_cast(bf16x8, wv);
            }
        }
#pragma unroll
        for (int dt = 0; dt < 8; ++dt)
#pragma unroll
            for (int si = 0; si < 2; ++si) {
                const s16x4 lo = tr_read(Vb + (32 * si) * AT_VP + dt * 32), hi = tr_read(Vb + (32 * si + 16) * AT_VP + dt * 32);
                const bf16x8 vf = (bf16x8){lo[0], lo[1], lo[2], lo[3], hi[0], hi[1], hi[2], hi[3]};
                o[0][dt] = __builtin_amdgcn_mfma_f32_16x16x32_bf16(vf, pf[0][si], o[0][dt], 0, 0, 0);
                o[1][dt] = __builtin_amdgcn_mfma_f32_16x16x32_bf16(vf, pf[1][si], o[1][dt], 0, 0, 0);
            }
        if (t + 1 < NT) {
            const int nb = buf ^ 1;
#pragma unroll
            for (int i = 0; i < 2; ++i) { *(LAS u32x4*)(lds + AT_K0 + nb * AT_KB + kdst + i * 32 * AT_KP) = kr[i]; *(LAS u32x4*)(lds + AT_V0 + nb * AT_VB + vdst + i * 32 * AT_VP) = vr[i]; }
        }
        __syncthreads();
    }
    l0 += __shfl_xor(l0, 16); l0 += __shfl_xor(l0, 32); l1 += __shfl_xor(l1, 16); l1 += __shfl_xor(l1, 32);
    const float i0 = 1.0f / l0, i1 = lam / l1;
    float ss = 0.f;
#pragma unroll
    for (int dt = 0; dt < 8; ++dt)
#pragma unroll
        for (int j = 0; j < 4; ++j) { const float v = o[0][dt][j] * i0 - o[1][dt][j] * i1; o[0][dt][j] = v; ss += v * v; }
    ss += __shfl_xor(ss, 16); ss += __shfl_xor(ss, 32);
    const float rs = __builtin_amdgcn_rsqf(ss * (1.0f / 128.0f) + EPS) * 0.8f;
    bf16_t* op = UQ + (size_t)(row0 + q0 + 16 * w + r16) * DM + 512 + 128 * h + 4 * fq;
#pragma unroll
    for (int dt = 0; dt < 8; ++dt) {
        const f32x4 gsl = *(const f32x4*)(subln + 16 * dt + 4 * fq);
        u32x2 wv; wv.x = cvtpk(o[0][dt][0] * rs * gsl[0], o[0][dt][1] * rs * gsl[1]); wv.y = cvtpk(o[0][dt][2] * rs * gsl[2], o[0][dt][3] * rs * gsl[3]);
        *(u32x2*)(op + 16 * dt) = wv;
    }
}

constexpr int SG_P = 144, SG_TILE = 128 * SG_P;
__device__ __forceinline__ void sgu_unit(LAS unsigned char* lds, int x, bf16_t* UQ, const bf16_t* VA, const float* stv, const float* sgn, const bf16_t* SW, const float* sgb) {
    const int tid = threadIdx.x, lane = tid & 63, w = __builtin_amdgcn_readfirstlane(tid >> 6), r16 = lane & 15, fq = lane >> 4;
    const int chunk = x >> 1, half = x & 1, r0 = chunk * 128;
#pragma unroll
    for (int i = 0; i < 8; ++i) {
        const int id = tid + 512 * i, s = id >> 5, ch = id & 31, g2 = ch >> 3, d8 = ch & 7;
        const u32x4 v = *(const u32x4*)(VA + (size_t)(r0 + s) * 512 + 256 * half + 8 * ch);
        const float rs = rstd_from(stv, r0 + s, 8, 1.0f / 512.0f);
        const f32x4 g0 = *(const f32x4*)(sgn + 256 * half + 8 * ch), g1 = *(const f32x4*)(sgn + 256 * half + 8 * ch + 4);
        u32x4 o; o.x = cvtpk(bflo(v.x) * rs * g0[0], bfhi(v.x) * rs * g0[1]); o.y = cvtpk(bflo(v.y) * rs * g0[2], bfhi(v.y) * rs * g0[3]);
        o.z = cvtpk(bflo(v.z) * rs * g1[0], bfhi(v.z) * rs * g1[1]); o.w = cvtpk(bflo(v.w) * rs * g1[2], bfhi(v.w) * rs * g1[3]);
        *(LAS u32x4*)(lds + g2 * SG_TILE + s * SG_P + d8 * 16) = o;
    }
    __syncthreads();
    const int g2 = w & 3, th = w >> 2, g = 4 * half + g2;
    const LAS unsigned char* tb = lds + g2 * SG_TILE + (4 * fq + (r16 >> 2)) * SG_P + (r16 & 3) * 8;
    bf16x8 af[4][4];
#pragma unroll
    for (int dt = 0; dt < 4; ++dt)
#pragma unroll
        for (int ks = 0; ks < 4; ++ks) { const s16x4 lo = tr_read(tb + (32 * ks) * SG_P + dt * 32), hi = tr_read(tb + (32 * ks + 16) * SG_P + dt * 32);
            af[dt][ks] = (bf16x8){lo[0], lo[1], lo[2], lo[3], hi[0], hi[1], hi[2], hi[3]}; }
#pragma unroll
    for (int tt = 0; tt < 4; ++tt) {
        const int t = 64 * th + 16 * tt + r16;
        bf16x8 bfr[4];
#pragma unroll
        for (int ks = 0; ks < 4; ++ks) bfr[ks] = *(const bf16x8*)(SW + ((size_t)(g * 128 + t) * 128 + 32 * ks + 8 * fq));
        const float bt = sgb[g * 128 + t];
        bf16_t* up = UQ + (size_t)(r0 + t) * DM + 64 * g + 4 * fq;
#pragma unroll
        for (int dt = 0; dt < 4; ++dt) {
            f32x4 a = (f32x4){0.f, 0.f, 0.f, 0.f};
#pragma unroll
            for (int ks = 0; ks < 4; ++ks) a = __builtin_amdgcn_mfma_f32_16x16x32_bf16(af[dt][ks], bfr[ks], a, 0, 0, 0);
            const u32x2 uv = *(const u32x2*)(up + 16 * dt);
            u32x2 wv; wv.x = cvtpk(bflo(uv.x) * (a[0] + bt), bfhi(uv.x) * (a[1] + bt)); wv.y = cvtpk(bflo(uv.y) * (a[2] + bt), bfhi(uv.y) * (a[3] + bt));
            *(u32x2*)(up + 16 * dt) = wv;
        }
    }
    __syncthreads();
}

constexpr int N_PHASES = 11;
__global__ void __launch_bounds__(512, 2) fwd_megakernel(Params P) {
    extern __shared__ __attribute__((aligned(16))) unsigned char lds_raw[];
    LAS unsigned char* lds = (LAS unsigned char*)lds_raw;
    cg::grid_group grid = cg::this_grid();
    const int tid = threadIdx.x, lane = tid & 63, wave = __builtin_amdgcn_readfirstlane(tid >> 6);
    const int G = gridDim.x, bx = blockIdx.x, vcu = (G % 8 == 0) ? (bx % 8) * (G / 8) + bx / 8 : bx;
    unsigned char* ws = P.ws;
    const int lo = P.ph_lo, hi = P.ph_hi;
#define IN(k) (lo <= (k) && (k) < hi)
#define SEAM(k) do { if (IN(k) && IN((k) + 1)) grid.sync(); } while (0)
    float* STA = (float*)(ws + WS_STA); float* STV = (float*)(ws + WS_STV);
    bf16_t* XB = (bf16_t*)(ws + WS_XB); bf16_t* UQ = (bf16_t*)(ws + WS_UQ); bf16_t* ACT = (bf16_t*)(ws + WS_ACT);

    if (IN(0)) { prologue(P, lds, vcu * 8 + wave, G * 8, wave, lane); }
    SEAM(0);
    if (IN(1)) {
        pg8::Gemm g{XB, (const bf16_t*)(ws + WS_W1IN), MT, 2 * DFF, DM}; pg8::StaticOrder S; S.init(MT, 2 * DFF, G, bx);
        EpiSwiGLU E{ACT, STA, 1}; pg8::gemm_phase(lds, g, S, E);
    }
    SEAM(1);
    if (IN(2)) {
        pg8::Gemm g{ACT, (const bf16_t*)(ws + WS_W1OUT), MT, DM, DFF}; pg8::StaticOrder S; S.init(MT, DM, G, bx);
        EpiRes E{P.in[0], P.in[1] - (size_t)MP * DM, P.out, XB, STA, 0.5f}; pg8::gemm_phase(lds, g, S, E);
    }
    SEAM(2);
    if (IN(3)) {
        pg8::Gemm g{XB, (const bf16_t*)(ws + WS_WIN), MT, NA1, DM}; pg8::StaticOrder S; S.init(MT, NA1, G, bx);
        EpiMixA E{UQ, (bf16_t*)(ws + WS_VA), (bf16_t*)(ws + WS_KB), (bf16_t*)(ws + WS_VB), STA, STV, P.in[12], P.in[13]}; pg8::gemm_phase(lds, g, S, E);
    }
    SEAM(3);
    if (IN(4)) {
        const float d1 = wave_sum(P.in[14][lane] * P.in[15][lane]), d2 = wave_sum(P.in[16][lane] * P.in[17][lane]);
        const float lam = expf(d1) - expf(d2) + 0.2f;
        float mq = fabsf(P.in[12][lane]), mk = fabsf(P.in[13][lane]), mb = fmaxf(P.in[2][lane], P.in[2][64 + lane]);
#pragma unroll
        for (int o = 1; o < 64; o <<= 1) { mq = fmaxf(mq, __shfl_xor(mq, o)); mk = fmaxf(mk, __shfl_xor(mk, o)); mb = fmaxf(mb, __shfl_xor(mb, o)); }
        const float bmax = 8.0f * mq * mk + mb;
        const bf16_t* KB = (const bf16_t*)(ws + WS_KB); const bf16_t* VB = (const bf16_t*)(ws + WS_VB);
        for (int i = vcu; i < NSEQ_S * 4 * 32; i += G) { const int sh = i >> 5, qb = i & 31; attn_unit(lds, NSEQ_P + (sh >> 2), sh & 3, qb, UQ, KB, VB, P.in[2], P.in[18], lam, bmax); }
        for (int i = vcu; i < NSEQ_P * 4 * 16; i += G) { const int sh = i >> 4, qb = i & 15; attn_unit(lds, sh >> 2, sh & 3, qb, UQ, KB, VB, P.in[2], P.in[18], lam, bmax); }
        for (int x = vcu; x < (MT / 128) * 2; x += G) sgu_unit(lds, x, UQ, (const bf16_t*)(ws + WS_VA), STV, P.in[9], (const bf16_t*)(ws + WS_SGUW), P.in[11]);
    }
    SEAM(4);
    if (IN(5)) {
        pg8::Gemm g{XB, (const bf16_t*)(ws + WS_WIN) + (size_t)NA1 * DM, MT, NG, DM}; pg8::StaticOrder S; S.init(MT, NG, G, bx);
        EpiGate E{(bf16_t*)(ws + WS_GA), (bf16_t*)(ws + WS_GB), STA, P.in[8]}; pg8::gemm_phase(lds, g, S, E);
    }
    SEAM(5);
    if (IN(6)) {
        pg8::Gemm g{UQ, (const bf16_t*)(ws + WS_WP), MT, DM, DM}; pg8::StaticOrder S; S.init(MT, DM, G, bx);
        EpiMerge E{(const bf16_t*)(ws + WS_GA), (const bf16_t*)(ws + WS_GB), (bf16_t*)(ws + WS_MG)}; pg8::gemm_phase(lds, g, S, E);
    }
    SEAM(6);
    if (IN(7)) {
        pg8::Gemm g{(const bf16_t*)(ws + WS_MG), (const bf16_t*)(ws + WS_WO), MT, DM, DM}; pg8::StaticOrder S; S.init(MT, DM, G, bx);
        EpiRes E{P.out, P.out, P.out, (bf16_t*)(ws + WS_XB2), STA, 1.0f}; pg8::gemm_phase(lds, g, S, E);
    }
    SEAM(7);
    if (IN(8)) {
        pg8::Gemm g{(const bf16_t*)(ws + WS_XB2), (const bf16_t*)(ws + WS_W2IN), MT, 2 * DFF, DM}; pg8::StaticOrder S; S.init(MT, 2 * DFF, G, bx);
        EpiSwiGLU E{ACT, STA, 16}; pg8::gemm_phase(lds, g, S, E);
    }
    SEAM(8);
    if (IN(9)) {
        pg8::Gemm g{ACT, (const bf16_t*)(ws + WS_W2OUT), MT, DM, DFF}; pg8::StaticOrder S; S.init(MT, DM, G, bx);
        EpiRes E{P.out, P.out, P.out, nullptr, STA, 0.5f}; pg8::gemm_phase(lds, g, S, E);
    }
    SEAM(9);
    if (IN(10)) {
        const float* fn = P.in[25];
        f32x4 gv[4];
#pragma unroll
        for (int j = 0; j < 4; ++j) gv[j] = ((const f32x4*)fn)[lane + 64 * j];
        for (int m = vcu * 8 + wave; m < MT; m += G * 8) {
            const float rs = rstd_from(STA, m, 16, 1.0f / 1024.0f);
            f32x4* x4 = (f32x4*)(P.out + (size_t)m * DM) + lane;
#pragma unroll
            for (int j = 0; j < 4; ++j) x4[64 * j] = x4[64 * j] * gv[j] * rs;
        }
    }
#undef IN
#undef SEAM
}

#ifndef MK_SPLIT
#define MK_SPLIT 0
#endif
extern "C" void kernel_launch(void* const* d_in, const int* in_sizes, int n_in, void* d_out, int out_size, void* d_ws, size_t ws_size, hipStream_t stream) {
    static int grid = 0;
    if (grid == 0) {
        if (n_in != 26 || out_size != MT * DM || ws_size < WS_END) { fprintf(stderr, "kernel_launch: unexpected shapes: n_in %d out %d ws %zu (need %zu)\n", n_in, out_size, ws_size, (size_t)WS_END); grid = -1; return; }
        int dev = 0, cus = 0, per_cu = 0;
        hipGetDevice(&dev); hipDeviceGetAttribute(&cus, hipDeviceAttributeMultiprocessorCount, dev);
        if (hipFuncSetAttribute((const void*)fwd_megakernel, hipFuncAttributeMaxDynamicSharedMemorySize, LDS_BYTES) != hipSuccess) { fprintf(stderr, "kernel_launch: hipFuncSetAttribute failed\n"); grid = -1; return; }
        if (hipOccupancyMaxActiveBlocksPerMultiprocessor(&per_cu, (const void*)fwd_megakernel, 512, LDS_BYTES) != hipSuccess || per_cu < 1) { fprintf(stderr, "kernel_launch: occupancy query says %d\n", per_cu); per_cu = 1; }
        (void)hipGetLastError();
        grid = cus * 1;
    }
    if (grid < 0) return;
    Params p{};
    for (int i = 0; i < 26; ++i) p.in[i] = (const float*)d_in[i];
    p.out = (float*)d_out; p.ws = (unsigned char*)d_ws;
#if MK_SPLIT
    for (int k = 0; k < N_PHASES; ++k) { p.ph_lo = k; p.ph_hi = k + 1; hipLaunchKernelGGL(fwd_megakernel, dim3(grid), dim3(512), LDS_BYTES, stream, p); }
#else
    p.ph_lo = 0; p.ph_hi = N_PHASES;
    void* args[] = {&p};
    hipError_t e = hipLaunchCooperativeKernel((const void*)fwd_megakernel, dim3(grid), dim3(512), args, LDS_BYTES, stream);
    if (e != hipSuccess) fprintf(stderr, "kernel_launch: cooperative launch failed: %s (grid %d)\n", hipGetErrorString(e), grid);
#endif
}
```

```cpp
#include <hip/hip_runtime.h>
#include <hip/hip_cooperative_groups.h>
#include <cstdio>
#include <cstdint>
namespace cg = cooperative_groups;

#define LAS __attribute__((address_space(3)))
typedef unsigned short bf16_t;
typedef short bf16x8 __attribute__((ext_vector_type(8)));
typedef short s16x4 __attribute__((ext_vector_type(4)));
typedef float f32x4 __attribute__((ext_vector_type(4)));
typedef float f32x2 __attribute__((ext_vector_type(2)));
typedef unsigned u32x4 __attribute__((ext_vector_type(4)));
typedef unsigned u32x2 __attribute__((ext_vector_type(2)));
typedef __bf16 bf16x2_t __attribute__((ext_vector_type(2)));

constexpr int DM = 1024, DFF = 2816, MP = 32768, MS = 16384, MT = MP + MS;
constexpr int NSEQ_P = 16, SEQ_P = 2048, NSEQ_S = 4, SEQ_S = 4096;
constexpr int NA1 = 2560, NG = 2048, NIN = NA1 + NG;
constexpr float EPS = 1e-6f;
constexpr float LOG2E = 1.4426950408889634f;
constexpr float QSCALE = 0.125f * LOG2E;

constexpr size_t MiB = 1u << 20;
constexpr size_t WS_STA = 0, WS_STV = 3 * MiB;
constexpr size_t WS_W1IN = 6 * MiB;
constexpr size_t WS_W1OUT = WS_W1IN + (size_t)5632 * 1024 * 2;
constexpr size_t WS_WIN = WS_W1OUT + (size_t)1024 * 2816 * 2;
constexpr size_t WS_WP = WS_WIN + (size_t)4608 * 1024 * 2;
constexpr size_t WS_WO = WS_WP + (size_t)1024 * 1024 * 2;
constexpr size_t WS_W2IN = WS_WO + (size_t)1024 * 1024 * 2;
constexpr size_t WS_W2OUT = WS_W2IN + (size_t)5632 * 1024 * 2;
constexpr size_t WS_SGUW = WS_W2OUT + (size_t)1024 * 2816 * 2;
constexpr size_t WS_R = 53 * MiB;
static_assert(WS_SGUW + 8 * 128 * 128 * 2 <= WS_R, "weights fit");
constexpr size_t WS_XB = WS_R;
constexpr size_t WS_MG = WS_R + 192 * MiB;
constexpr size_t WS_UQ = WS_R + 96 * MiB;
constexpr size_t WS_XB2 = WS_UQ;
constexpr size_t WS_VA = WS_R + 192 * MiB;
constexpr size_t WS_KB = WS_R + 240 * MiB;
constexpr size_t WS_VB = WS_R + 288 * MiB;
constexpr size_t WS_GA = WS_R + 192 * MiB;
constexpr size_t WS_GB = WS_R + 288 * MiB;
constexpr size_t WS_ACT = WS_R + 192 * MiB;
constexpr size_t WS_END = WS_ACT + (size_t)MT * DFF * 2;
constexpr size_t WS_CTL = WS_END, CTL_BYTES = 16384;
static_assert(WS_CTL + CTL_BYTES <= 512 * MiB, "workspace");
constexpr int MISC_OFF = 131072;

constexpr int LDS_BYTES = 147456;

__device__ __forceinline__ unsigned cvtpk(float lo, float hi) { f32x2 v = {lo, hi}; bf16x2_t b = __builtin_convertvector(v, bf16x2_t); return __builtin_bit_cast(unsigned, b); }
__device__ __forceinline__ float bflo(unsigned w) { return __uint_as_float(w << 16); }
__device__ __forceinline__ float bfhi(unsigned w) { return __uint_as_float(w & 0xffff0000u); }
__device__ __forceinline__ float fast_rcp(float x) { return __builtin_amdgcn_rcpf(x); }
__device__ __forceinline__ float fast_exp2(float x) { return __builtin_amdgcn_exp2f(x); }
__device__ __forceinline__ float sigmoidf_(float x) { return fast_rcp(1.0f + fast_exp2(-LOG2E * x)); }
__device__ __forceinline__ float siluf_(float x) { return x * sigmoidf_(x); }
__device__ __forceinline__ float gelu_tanh(float x) { const float z = x + 0.044715f * x * x * x; return x * fast_rcp(1.0f + fast_exp2((-2.0f * 0.7978845608028654f * LOG2E) * z)); }
__device__ __forceinline__ f32x4 exp2_4(f32x4 t) { return (f32x4){fast_exp2(t[0]), fast_exp2(t[1]), fast_exp2(t[2]), fast_exp2(t[3])}; }
__device__ __forceinline__ f32x4 rcp_4(f32x4 t) { return (f32x4){fast_rcp(t[0]), fast_rcp(t[1]), fast_rcp(t[2]), fast_rcp(t[3])}; }
__device__ __forceinline__ f32x4 sig_from_negl2(f32x4 t) { return rcp_4(exp2_4(t) + 1.0f); }
__device__ __forceinline__ u32x2 pack4(f32x4 v) { u32x2 w; w.x = cvtpk(v[0], v[1]); w.y = cvtpk(v[2], v[3]); return w; }
__device__ __forceinline__ float wave_sum(float v) {
#pragma unroll
    for (int o = 1; o < 64; o <<= 1) v += __shfl_xor(v, o);
    return v;
}
__device__ __forceinline__ float rstd_from(const float* st, int row, int np, float inv_dim) {
    float s = 0.f;
    if (np == 1) s = st[(size_t)row * 16];
    else { const f32x4* p = (const f32x4*)(st + (size_t)row * 16);
#pragma unroll 4
        for (int i = 0; i < np / 4; ++i) { const f32x4 v = p[i]; s += (v[0] + v[1]) + (v[2] + v[3]); } }
    return __builtin_amdgcn_rsqf(s * inv_dim + EPS);
}


__device__ __forceinline__ void rstd8(const float* st, int rbase, int fq, float inv_dim, float (&rs)[2][4]) {
    f32x4 v[2][4];
#pragma unroll
    for (int ai = 0; ai < 2; ++ai)
#pragma unroll
        for (int m = 0; m < 4; ++m) v[ai][m] = *(const f32x4*)(st + (size_t)(rbase + ai * 128 + m * 16) * 16 + 4 * fq);
#pragma unroll
    for (int ai = 0; ai < 2; ++ai)
#pragma unroll
        for (int m = 0; m < 4; ++m) { float q = (v[ai][m][0] + v[ai][m][1]) + (v[ai][m][2] + v[ai][m][3]); q += __shfl_xor(q, 16); q += __shfl_xor(q, 32); rs[ai][m] = __builtin_amdgcn_rsqf(q * inv_dim + EPS); }
}

namespace pg8 {
constexpr int BM = 256, BK = 64, HALF = 128, HTB = HALF * BK * 2, STAGE_BYTES = 8 * HTB, NXCD = 8, WGM = 8;
__host__ __device__ __forceinline__ int lds_byte(int r, int c) { const int st = (r >> 4) * 2 + (c >> 5), rr = r & 15, cc = c & 31, ob = rr * 64 + cc * 2; return st * 1024 + (ob ^ (((ob >> 9) & 1) << 5)); }
__host__ __device__ __forceinline__ void stage_rc(int b, int& R, int& C) { const int st = b / 1024, sb = b % 1024, swz = sb ^ (((sb >> 9) & 1) << 5); R = (st >> 1) * 16 + swz / 64; C = (st & 1) * 32 + (swz % 64) / 2; }
__host__ __device__ __forceinline__ int perm32(int rho) { const int n = rho >> 4, i = rho & 15; return 8 * (i >> 2) + 4 * n + (i & 3); }

struct Unit { int pm, pn; };
struct Gemm { const bf16_t* A; const bf16_t* Bt; int M, N, K; };

struct StaticOrder {
    int nM, nN, nwg, G, c;
    __device__ void init(int M, int N, int G_, int c_) { nM = M / BM; nN = N / BM; nwg = nM * nN; G = G_; c = c_; }
    __device__ bool next(int i, Unit& u) const {
        const long L = (long)i * G + c; if (L >= nwg) return false;
        int wgid = (int)L; { const int q = nwg / NXCD, r = nwg % NXCD, xcd = wgid % NXCD, off = wgid / NXCD; wgid = (xcd < r ? xcd * (q + 1) : r * (q + 1) + (xcd - r) * q) + off; }
        const int nig = WGM * nN, gid = wgid / nig, fm = gid * WGM, gsz = (nM - fm) < WGM ? (nM - fm) : WGM;
        u.pm = fm + ((wgid % nig) % gsz); u.pn = (wgid % nig) / gsz; return true;
    }
};

template <class Epi>
__device__ __forceinline__ void gemm_phase(LAS unsigned char* lds, const Gemm g, const StaticOrder& S, const Epi& E) {
    const int tid = threadIdx.x, wid = __builtin_amdgcn_readfirstlane(tid >> 6), lane = tid & 63, wr = wid >> 2, wc = wid & 3, fr = lane & 15, fq = lane >> 4;
    const int K = g.K, nt = K / BK;
    unsigned voffA[2], voffB[2];
#pragma unroll
    for (int i = 0; i < 2; ++i) { int R, C; stage_rc(tid * 16 + i * 8192, R, C); const int Rb = (R & ~31) + perm32(R & 31);
        voffA[i] = (unsigned)(R * K + C) * 2u; voffB[i] = (unsigned)(Rb * K + C) * 2u; }
    const size_t kstep = (size_t)(BK * 2);
    const size_t hstep = (size_t)HALF * K * 2;
    const size_t tstep = 2 * hstep;
    const unsigned ldsw = (unsigned)wid * 1024u;
    const int aoff = lds_byte(wr * 64 + fr, fq * 8), boff = lds_byte(wc * 32 + fr, fq * 8);
#define PG8_SA(b, h) (((b) * 2 + (h)) * HTB)
#define PG8_SB(b, h) ((4 + (b) * 2 + (h)) * HTB)
#define PG8_STAGE(bufoff, gbase, voff) do { _Pragma("unroll") for (int _i = 0; _i < 2; ++_i) \
        __builtin_amdgcn_global_load_lds((const unsigned*)((const char*)(gbase) + (voff)[_i]), (LAS unsigned*)(lds + (bufoff) + ldsw + _i * 8192), 16, 0, 0); } while (0)
#define PG8_LDA(dst, b, h) do { _Pragma("unroll") for (int m = 0; m < 4; ++m) _Pragma("unroll") for (int k = 0; k < 2; ++k) dst[m][k] = *(const LAS bf16x8*)(lds + PG8_SA(b, h) + aoff + m * 2048 + k * 1024); } while (0)
#define PG8_LDB(dst, b, h) do { _Pragma("unroll") for (int n = 0; n < 2; ++n) _Pragma("unroll") for (int k = 0; k < 2; ++k) dst[n][k] = *(const LAS bf16x8*)(lds + PG8_SB(b, h) + boff + n * 2048 + k * 1024); } while (0)
#define PG8_MMA(ai, bj, At, Bt) do { __builtin_amdgcn_s_setprio(1); _Pragma("unroll") for (int m = 0; m < 4; ++m) _Pragma("unroll") for (int n = 0; n < 2; ++n) _Pragma("unroll") for (int k = 0; k < 2; ++k) \
        acc[ai][bj][m][n] = __builtin_amdgcn_mfma_f32_16x16x32_bf16(Bt[n][k], At[m][k], acc[ai][bj][m][n], 0, 0, 0); __builtin_amdgcn_s_setprio(0); } while (0)
#define PG8_WAIT_V(n) asm volatile("s_waitcnt vmcnt(" #n ")" ::: "memory")
#define PG8_WAIT_L(n) asm volatile("s_waitcnt lgkmcnt(" #n ")" ::: "memory")
#define PG8_BAR __builtin_amdgcn_s_barrier()
#define PG8_SCHED __builtin_amdgcn_sched_barrier(0)
    Unit cur, nxt; int ui = 0;
    if (!S.next(0, cur)) return;
    f32x4 acc[2][2][4][2];
#pragma unroll
    for (int a = 0; a < 2; ++a)
#pragma unroll
        for (int b = 0; b < 2; ++b)
#pragma unroll
            for (int m = 0; m < 4; ++m)
#pragma unroll
                for (int n = 0; n < 2; ++n) acc[a][b][m][n] = (f32x4){0.f, 0.f, 0.f, 0.f};
    bf16x8 At[4][2], B0[2][2], B1[2][2];
    const char* cA = (const char*)g.A + (size_t)cur.pm * tstep; const char* cB = (const char*)g.Bt + (size_t)cur.pn * tstep;
    PG8_STAGE(PG8_SB(0, 0), cB, voffB); PG8_STAGE(PG8_SB(0, 1), cB + hstep, voffB); PG8_STAGE(PG8_SA(0, 0), cA, voffA); PG8_STAGE(PG8_SA(0, 1), cA + hstep, voffA);
    if (wr == 1) PG8_BAR;
    PG8_WAIT_V(2); PG8_BAR;
    PG8_STAGE(PG8_SB(1, 0), cB + kstep, voffB); PG8_STAGE(PG8_SA(1, 0), cA + kstep, voffA); PG8_STAGE(PG8_SB(1, 1), cB + hstep + kstep, voffB);
    PG8_WAIT_V(6); PG8_BAR;
    for (;;) {
        const bool has_next = S.next(ui + 1, nxt);
        const char* nA = has_next ? (const char*)g.A + (size_t)nxt.pm * tstep : cA; const char* nB = has_next ? (const char*)g.Bt + (size_t)nxt.pn * tstep : cB;
        for (int t = 0; t < nt; t += 2) {
            const bool last = (t == nt - 2);
            const char* a1 = cA + (size_t)(t + 1) * kstep;
            const char* a2 = last ? nA : cA + (size_t)(t + 2) * kstep; const char* b2 = last ? nB : cB + (size_t)(t + 2) * kstep;
            const char* a3 = a2 + kstep; const char* b3 = b2 + kstep;
            if constexpr (Epi::MIDK > 0) { if (t == Epi::MIDK) E.mid(acc, cur, wr, wc, fr, fq); }
            PG8_LDB(B0, 0, 0); PG8_LDB(B1, 0, 1); PG8_SCHED; PG8_LDA(At, 0, 0); PG8_STAGE(PG8_SA(1, 1), a1 + hstep, voffA);
            PG8_WAIT_V(8); PG8_WAIT_L(0); PG8_BAR; PG8_MMA(0, 0, At, B0); PG8_MMA(0, 1, At, B1); PG8_BAR; PG8_SCHED;
            PG8_LDA(At, 0, 1); PG8_STAGE(PG8_SB(0, 0), b2, voffB); PG8_STAGE(PG8_SB(0, 1), b2 + hstep, voffB); PG8_STAGE(PG8_SA(0, 0), a2, voffA);
            PG8_WAIT_V(8); PG8_WAIT_L(0); PG8_BAR; PG8_MMA(1, 0, At, B0); PG8_MMA(1, 1, At, B1); PG8_BAR; PG8_SCHED;
            PG8_LDB(B0, 1, 0); PG8_LDB(B1, 1, 1); PG8_SCHED; PG8_LDA(At, 1, 0); PG8_STAGE(PG8_SA(0, 1), a2 + hstep, voffA);
            PG8_WAIT_V(8); PG8_WAIT_L(0); PG8_BAR; PG8_MMA(0, 0, At, B0); PG8_MMA(0, 1, At, B1); PG8_BAR; PG8_SCHED;
            PG8_LDA(At, 1, 1); PG8_STAGE(PG8_SB(1, 0), b3, voffB); PG8_STAGE(PG8_SB(1, 1), b3 + hstep, voffB); PG8_STAGE(PG8_SA(1, 0), a3, voffA);
            PG8_WAIT_V(8); PG8_WAIT_L(0); PG8_BAR; PG8_MMA(1, 0, At, B0); PG8_MMA(1, 1, At, B1); PG8_BAR; PG8_SCHED;
        }
        if (wr == 0) PG8_BAR;
        E(acc, cur, wr, wc, fr, fq);
        if (!has_next) break;
#pragma unroll
        for (int a = 0; a < 2; ++a)
#pragma unroll
            for (int b = 0; b < 2; ++b)
#pragma unroll
                for (int m = 0; m < 4; ++m)
#pragma unroll
                    for (int n = 0; n < 2; ++n) acc[a][b][m][n] = (f32x4){0.f, 0.f, 0.f, 0.f};
        cur = nxt; cA = nA; cB = nB; ++ui;
        if (wr == 1) PG8_BAR;
    }
    PG8_WAIT_V(0);
    PG8_BAR;
#undef PG8_SA
#undef PG8_SB
#undef PG8_STAGE
#undef PG8_LDA
#undef PG8_LDB
#undef PG8_MMA
#undef PG8_WAIT_V
#undef PG8_WAIT_L
#undef PG8_BAR
#undef PG8_SCHED
}
}
using pg8::Unit;
typedef f32x4 Acc[2][2][4][2];
#define FENCE() asm volatile("" ::: "memory")

struct EpiSwiGLU {
    static constexpr int MIDK = 0;
    bf16_t* O; const float* st;
    __device__ __forceinline__ void mid(Acc&, const Unit&, int, int, int, int) const {}
    __device__ __forceinline__ void operator()(const Acc& acc, const Unit& u, int wr, int wc, int fr, int fq) const {
        const int col = u.pn * 128 + wc * 32 + fq * 8;
        float rsv[2][4]; rstd8(st, u.pm * 256 + wr * 64 + fr, fq, 1.0f / 1024.0f, rsv);
#pragma unroll
        for (int ai = 0; ai < 2; ++ai)
#pragma unroll
            for (int m = 0; m < 4; ++m) {
                const int r = u.pm * 256 + ai * 128 + wr * 64 + m * 16 + fr;
                const float rs = rsv[ai][m], nrs = -LOG2E * rs, irs2 = fast_rcp(rs * rs);
                u32x4 w;
#pragma unroll
                for (int n = 0; n < 2; ++n) {
                    const f32x4 ga = acc[ai][0][m][n], ua = acc[ai][1][m][n];
                    const f32x4 sg = rcp_4(exp2_4(ga * nrs) * irs2 + irs2);
                    const u32x2 pk = pack4((ga * ua) * sg);
                    if (n == 0) { w.x = pk.x; w.y = pk.y; } else { w.z = pk.x; w.w = pk.y; }
                }
                *(u32x4*)(O + (size_t)r * DFF + col) = w;
            }
    }
};

template <bool RES_BF16, bool OUT_F32>
struct EpiRes {
    static constexpr int MIDK = 0;
    const float* baseA; const float* baseB; const bf16_t* resb; float* out; bf16_t* xb; float* st; float scale;
    __device__ __forceinline__ void mid(Acc&, const Unit&, int, int, int, int) const {}
    __device__ __forceinline__ void operator()(const Acc& acc, const Unit& u, int wr, int wc, int fr, int fq) const {
        const int col = u.pn * 256 + wc * 32 + fq * 8;
        const int rb = u.pm * 256 + wr * 64 + fr;
        const float* bbase = RES_BF16 ? nullptr : (rb < MP ? baseA : baseB) + (size_t)rb * DM + col;
        const bf16_t* rbase = RES_BF16 ? resb + (size_t)rb * DM + col : nullptr;
        f32x4 pre[2][2][2]; u32x4 preb[2][2];
#pragma unroll
        for (int bj = 0; bj < 2; ++bj) {
            if constexpr (RES_BF16) preb[0][bj] = *(const u32x4*)(rbase + bj * 128);
            else { pre[0][bj][0] = *(const f32x4*)(bbase + bj * 128); pre[0][bj][1] = *(const f32x4*)(bbase + bj * 128 + 4); }
        }
#pragma unroll
        for (int i = 0; i < 8; ++i) {
            const int ai = i >> 2, m = i & 3, cb = i & 1, nb = cb ^ 1;
            if (i < 7) { const int ai2 = (i + 1) >> 2, m2 = (i + 1) & 3; const size_t ro = (size_t)(ai2 * 128 + m2 * 16) * DM;
#pragma unroll
                for (int bj = 0; bj < 2; ++bj) {
                    if constexpr (RES_BF16) preb[nb][bj] = *(const u32x4*)(rbase + ro + bj * 128);
                    else { pre[nb][bj][0] = *(const f32x4*)(bbase + ro + bj * 128); pre[nb][bj][1] = *(const f32x4*)(bbase + ro + bj * 128 + 4); }
                }
            }
            FENCE();
            const int r = rb + ai * 128 + m * 16;
            float q = 0.f;
#pragma unroll
            for (int bj = 0; bj < 2; ++bj) {
                f32x4 b0, b1;
                if constexpr (RES_BF16) { const u32x4 w = preb[cb][bj]; b0 = (f32x4){bflo(w.x), bfhi(w.x), bflo(w.y), bfhi(w.y)}; b1 = (f32x4){bflo(w.z), bfhi(w.z), bflo(w.w), bfhi(w.w)}; }
                else { b0 = pre[cb][bj][0]; b1 = pre[cb][bj][1]; }
                const f32x4 v0 = b0 + acc[ai][bj][m][0] * scale, v1 = b1 + acc[ai][bj][m][1] * scale;
                if constexpr (OUT_F32) { float* op = out + (size_t)r * DM + col + bj * 128; *(f32x4*)op = v0; *(f32x4*)(op + 4) = v1; }
                q += (v0[0] * v0[0] + v0[1] * v0[1]) + (v0[2] * v0[2] + v0[3] * v0[3]) + (v1[0] * v1[0] + v1[1] * v1[1]) + (v1[2] * v1[2] + v1[3] * v1[3]);
                if (xb) { u32x4 w; w.x = cvtpk(v0[0], v0[1]); w.y = cvtpk(v0[2], v0[3]); w.z = cvtpk(v1[0], v1[1]); w.w = cvtpk(v1[2], v1[3]);
                    *(u32x4*)(xb + (size_t)r * DM + col + bj * 128) = w; }
            }
            q += __shfl_xor(q, 16); q += __shfl_xor(q, 32);
            if (fq == 0) st[(size_t)r * 16 + u.pn * 4 + wc] = q;
            FENCE();
        }
    }
};

struct EpiMixA {
    static constexpr int MIDK = 0;
    bf16_t* UQ; bf16_t* VA; bf16_t* KB; bf16_t* VB; const float* st; float* stv; const float* qn; const float* kn;
    __device__ __forceinline__ void mid(Acc&, const Unit&, int, int, int, int) const {}
    __device__ __forceinline__ void operator()(const Acc& acc, const Unit& u, int wr, int wc, int fr, int fq) const {
        const int t = u.pn;
        if (t < 4 || t >= 8) {
            bf16_t* base; int pitch, c0; const bool act = t < 4;
            if (t < 2) { base = UQ; pitch = DM; c0 = 256 * t; } else if (t < 4) { base = VA; pitch = 512; c0 = 256 * (t - 2); } else { base = VB; pitch = 512; c0 = 256 * (t - 8); }
            const int col = c0 + wc * 32 + fq * 8;
            float rsv[2][4]; rstd8(st, u.pm * 256 + wr * 64 + fr, fq, 1.0f / 1024.0f, rsv);
#pragma unroll
            for (int ai = 0; ai < 2; ++ai)
#pragma unroll
                for (int m = 0; m < 4; ++m) {
                    const int r = u.pm * 256 + ai * 128 + wr * 64 + m * 16 + fr;
                    const float rs = rsv[ai][m], irs = fast_rcp(rs);
                    const float k1 = (-2.0f * 0.7978845608028654f * LOG2E) * rs, k3 = (-2.0f * 0.7978845608028654f * LOG2E * 0.044715f) * rs * rs * rs;
                    float q = 0.f;
#pragma unroll
                    for (int bj = 0; bj < 2; ++bj) {
                        u32x4 w;
#pragma unroll
                        for (int n = 0; n < 2; ++n) {
                            f32x4 v;
                            if (act) {
                                const f32x4 a = acc[ai][bj][m][n];
                                const f32x4 t = a * ((a * a) * k3 + k1);
                                v = a * rcp_4(exp2_4(t) * irs + irs);
                            } else v = acc[ai][bj][m][n] * rs;
                            if (t == 2 || t == 3) { const f32x4 v2 = v * v; q += (v2[0] + v2[1]) + (v2[2] + v2[3]); }
                            const u32x2 pk = pack4(v);
                            if (n == 0) { w.x = pk.x; w.y = pk.y; } else { w.z = pk.x; w.w = pk.y; }
                        }
                        *(u32x4*)(base + (size_t)r * pitch + col + bj * 128) = w;
                    }
                    if (t == 2 || t == 3) { q += __shfl_xor(q, 16); q += __shfl_xor(q, 32); if (fq == 0) stv[(size_t)r * 16 + (t - 2) * 4 + wc] = q; }
                }
        } else {
            const bool isq = t < 6;
            const float* gn = isq ? qn : kn; const float sc = isq ? QSCALE : 1.0f;
            f32x4 gv[2][2];
#pragma unroll
            for (int bj = 0; bj < 2; ++bj)
#pragma unroll
                for (int n = 0; n < 2; ++n) gv[bj][n] = *(const f32x4*)(gn + 32 * bj + 8 * fq + 4 * n) * sc;
            bf16_t* base = isq ? (UQ + 512 + 256 * (t - 4)) : (KB + 256 * (t - 6));
            const int pitch = isq ? DM : 512;
            const int col = wc * 64 + fq * 8;
            float rsv[2][4]; rstd8(st, u.pm * 256 + wr * 64 + fr, fq, 1.0f / 1024.0f, rsv);
#pragma unroll
            for (int ai = 0; ai < 2; ++ai)
#pragma unroll
                for (int m = 0; m < 4; ++m) {
                    const int r = u.pm * 256 + ai * 128 + wr * 64 + m * 16 + fr;
                    const float rs = rsv[ai][m];
                    f32x4 v[2][2]; float q = 0.f;
#pragma unroll
                    for (int bj = 0; bj < 2; ++bj)
#pragma unroll
                        for (int n = 0; n < 2; ++n) { v[bj][n] = acc[ai][bj][m][n] * rs; const f32x4 x = v[bj][n]; q += (x[0] * x[0] + x[1] * x[1]) + (x[2] * x[2] + x[3] * x[3]); }
                    q += __shfl_xor(q, 16); q += __shfl_xor(q, 32);
                    const float rq = __builtin_amdgcn_rsqf(q * (1.0f / 64.0f) + EPS);
#pragma unroll
                    for (int bj = 0; bj < 2; ++bj) {
                        const f32x4 a = v[bj][0] * gv[bj][0] * rq, b = v[bj][1] * gv[bj][1] * rq;
                        u32x4 w; w.x = cvtpk(a[0], a[1]); w.y = cvtpk(a[2], a[3]); w.z = cvtpk(b[0], b[1]); w.w = cvtpk(b[2], b[3]);
                        *(u32x4*)(base + (size_t)r * pitch + col + bj * 32) = w;
                    }
                }
        }
    }
};

struct EpiGate {
    static constexpr int MIDK = 0;
    bf16_t* GA; bf16_t* GB; const float* st; const float* gbias;
    __device__ __forceinline__ void mid(Acc&, const Unit&, int, int, int, int) const {}
    __device__ __forceinline__ void operator()(const Acc& acc, const Unit& u, int wr, int wc, int fr, int fq) const {
        bf16_t* base = u.pn < 4 ? GA : GB; const int col = (u.pn & 3) * 256 + wc * 32 + fq * 8;
        const float* bp = gbias + u.pn * 256 + wc * 32 + fq * 8;
        f32x4 bv[2][2];
#pragma unroll
        for (int bj = 0; bj < 2; ++bj)
#pragma unroll
            for (int n = 0; n < 2; ++n) bv[bj][n] = *(const f32x4*)(bp + bj * 128 + 4 * n) * (-LOG2E);
        float rsv[2][4]; rstd8(st, u.pm * 256 + wr * 64 + fr, fq, 1.0f / 1024.0f, rsv);
#pragma unroll
        for (int ai = 0; ai < 2; ++ai)
#pragma unroll
            for (int m = 0; m < 4; ++m) {
                const int r = u.pm * 256 + ai * 128 + wr * 64 + m * 16 + fr;
                const float nrs = -LOG2E * rsv[ai][m];
#pragma unroll
                for (int bj = 0; bj < 2; ++bj) {
                    const u32x2 p0 = pack4(sig_from_negl2(acc[ai][bj][m][0] * nrs + bv[bj][0])), p1 = pack4(sig_from_negl2(acc[ai][bj][m][1] * nrs + bv[bj][1]));
                    u32x4 w; w.x = p0.x; w.y = p0.y; w.z = p1.x; w.w = p1.y;
                    *(u32x4*)(base + (size_t)r * DM + col + bj * 128) = w;
                }
            }
    }
};

struct EpiMerge {
    static constexpr int MIDK = 8;
    const bf16_t* GA; const bf16_t* GB; bf16_t* MG;
    __device__ __forceinline__ void mid(Acc& acc, const Unit& u, int wr, int wc, int fr, int fq) const {
        int col = u.pn * 256 + wc * 32 + fq * 8, rb = u.pm * 256 + wr * 64 + fr;
        asm volatile("" : "+v"(col), "+v"(rb));
#pragma unroll
        for (int ai = 0; ai < 2; ++ai)
#pragma unroll
            for (int m = 0; m < 4; ++m) {
                const int r = rb + ai * 128 + m * 16;
#pragma unroll
                for (int bj = 0; bj < 2; ++bj) {
                    const u32x4 a = *(const u32x4*)(GA + (size_t)r * DM + col + bj * 128), b = *(const u32x4*)(GB + (size_t)r * DM + col + bj * 128);
                    f32x4 r0, r1;
                    r0[0] = bflo(a.x) * fast_rcp(bflo(b.x)); r0[1] = bfhi(a.x) * fast_rcp(bfhi(b.x)); r0[2] = bflo(a.y) * fast_rcp(bflo(b.y)); r0[3] = bfhi(a.y) * fast_rcp(bfhi(b.y));
                    r1[0] = bflo(a.z) * fast_rcp(bflo(b.z)); r1[1] = bfhi(a.z) * fast_rcp(bfhi(b.z)); r1[2] = bflo(a.w) * fast_rcp(bflo(b.w)); r1[3] = bfhi(a.w) * fast_rcp(bfhi(b.w));
                    acc[ai][bj][m][0] *= r0; acc[ai][bj][m][1] *= r1;
                }
                if (m & 1) FENCE();
            }
    }
    __device__ __forceinline__ void operator()(const Acc& acc, const Unit& u, int wr, int wc, int fr, int fq) const {
        const int col = u.pn * 256 + wc * 32 + fq * 8;
        u32x4 gb[2][4][2];
#pragma unroll
        for (int ai = 0; ai < 2; ++ai)
#pragma unroll
            for (int m = 0; m < 4; ++m)
#pragma unroll
                for (int bj = 0; bj < 2; ++bj) gb[ai][m][bj] = *(const u32x4*)(GB + (size_t)(u.pm * 256 + ai * 128 + wr * 64 + m * 16 + fr) * DM + col + bj * 128);
        FENCE();
#pragma unroll
        for (int ai = 0; ai < 2; ++ai)
#pragma unroll
            for (int m = 0; m < 4; ++m) {
                const int r = u.pm * 256 + ai * 128 + wr * 64 + m * 16 + fr;
#pragma unroll
                for (int bj = 0; bj < 2; ++bj) {
                    const u32x4 b = gb[ai][m][bj];
                    const f32x4 v0 = acc[ai][bj][m][0], v1 = acc[ai][bj][m][1];
                    u32x4 w; w.x = cvtpk(v0[0] * bflo(b.x), v0[1] * bfhi(b.x)); w.y = cvtpk(v0[2] * bflo(b.y), v0[3] * bfhi(b.y));
                    w.z = cvtpk(v1[0] * bflo(b.z), v1[1] * bfhi(b.z)); w.w = cvtpk(v1[2] * bflo(b.w), v1[3] * bfhi(b.w));
                    *(u32x4*)(MG + (size_t)r * DM + col + bj * 128) = w;
                }
                if (m & 1) FENCE();
            }
    }
};

struct Params { const float* in[26]; float* out; unsigned char* ws; int ph_lo, ph_hi; };

__device__ __forceinline__ void transpose_item(const float* W, int ldw, int k0, int srccol0, const float* gain, bf16_t* dst, int dpitch, int drow0, int dk0, LAS float* scr, int lane) {
    float tv[32];
#pragma unroll
    for (int i = 0; i < 32; ++i) { const int kk = 2 * i + (lane >> 5); tv[i] = W[(size_t)(k0 + kk) * ldw + srccol0 + (lane & 31)]; }
    if (gain) {
#pragma unroll
        for (int i = 0; i < 32; ++i) tv[i] *= gain[k0 + 2 * i + (lane >> 5)];
    }
#pragma unroll
    for (int i = 0; i < 32; ++i) { const int kk = 2 * i + (lane >> 5); scr[kk * 33 + (lane & 31)] = tv[i]; }
    asm volatile("s_waitcnt lgkmcnt(0)" ::: "memory");
    const int c = lane & 7;
#pragma unroll
    for (int j = 0; j < 4; ++j) { const int n = (lane >> 3) + 8 * j; const LAS float* s = scr + (8 * c) * 33 + n;
        u32x4 o; o.x = cvtpk(s[0 * 33], s[1 * 33]); o.y = cvtpk(s[2 * 33], s[3 * 33]); o.z = cvtpk(s[4 * 33], s[5 * 33]); o.w = cvtpk(s[6 * 33], s[7 * 33]);
        *(u32x4*)(dst + (size_t)(drow0 + n) * dpitch + dk0 + k0 + 8 * c) = o; }
    asm volatile("s_waitcnt lgkmcnt(0)" ::: "memory");
}
__device__ __forceinline__ int map_ffn_in(int n) { const int pn = n >> 8, p = n & 255; return p < 128 ? 128 * pn + p : DFF + 128 * pn + (p - 128); }
__device__ __forceinline__ int map_win(int n) { if (n < 1024 || n >= 2048) return n; const int pn = n >> 8, p = n & 255, bj = p >> 7, wc = (p & 127) >> 5, j = p & 31; return 256 * pn + 64 * wc + 32 * bj + j; }

__device__ __forceinline__ void prologue(const Params& P, LAS unsigned char* lds, int gw, int NGW, int wave, int lane) {
    unsigned char* ws = P.ws;
    LAS float* scr = (LAS float*)(lds + wave * 16384);
    constexpr int I_IN = 16 * 176, I_OUT = 44 * 32, I_WIN = 16 * 144, I_P = 8 * 32, I_O = 16 * 32;
    constexpr int NITEMS = 2 * I_IN + 2 * I_OUT + I_WIN + 2 * I_P + I_O;
    for (int it = gw; it < NITEMS; it += NGW) {
        int r = it;
        if (r < 2 * I_IN) { const int w = r / I_IN; r -= w * I_IN; const int kb = r / 176, nb = r % 176;
            transpose_item(P.in[w ? 23 : 4], 2 * DFF, 64 * kb, map_ffn_in(32 * nb), P.in[w ? 22 : 3], (bf16_t*)(ws + (w ? WS_W2IN : WS_W1IN)), 1024, 32 * nb, 0, scr, lane); continue; }
        r -= 2 * I_IN;
        if (r < 2 * I_OUT) { const int w = r / I_OUT; r -= w * I_OUT; const int kb = r / 32, nb = r % 32;
            transpose_item(P.in[w ? 24 : 5], DM, 64 * kb, 32 * nb, nullptr, (bf16_t*)(ws + (w ? WS_W2OUT : WS_W1OUT)), DFF, 32 * nb, 0, scr, lane); continue; }
        r -= 2 * I_OUT;
        if (r < I_WIN) { const int kb = r / 144, nb = r % 144;
            transpose_item(P.in[7], NIN, 64 * kb, map_win(32 * nb), P.in[6], (bf16_t*)(ws + WS_WIN), 1024, 32 * nb, 0, scr, lane); continue; }
        r -= I_WIN;
        if (r < 2 * I_P) { const int w = r / I_P; r -= w * I_P; const int kb = r / 32, nb = r % 32;
            transpose_item(P.in[w ? 20 : 19], DM, 64 * kb, 32 * nb, nullptr, (bf16_t*)(ws + WS_WP), 1024, 32 * nb, w ? 512 : 0, scr, lane); continue; }
        r -= 2 * I_P;
        { const int kb = r / 32, nb = r % 32; transpose_item(P.in[21], DM, 64 * kb, 32 * nb, nullptr, (bf16_t*)(ws + WS_WO), 1024, 32 * nb, 0, scr, lane); }
    }
    { bf16_t* d = (bf16_t*)(ws + WS_SGUW); const float* s = P.in[10];
      for (int i = gw * 64 + lane; i < 8 * 128 * 128; i += NGW * 64) { const int lo = i & 31, hi = i & ~31, f = lo >> 3, e = lo & 7; const int src = hi + (e < 4 ? 4 * f + e : 16 + 4 * f + e - 4);
          const unsigned w = cvtpk(s[src], 0.f); d[i] = (bf16_t)(w & 0xffffu); } }
    { bf16_t* xb = (bf16_t*)(ws + WS_XB); float* st = (float*)(ws + WS_STA);
      for (int m = gw; m < MT; m += 4 * NGW) {
          const float* xr[4]; int mr[4]; bool ok[4];
#pragma unroll
          for (int k = 0; k < 4; ++k) { const int mk = m + k * NGW; ok[k] = mk < MT; mr[k] = ok[k] ? mk : m; xr[k] = (mr[k] < MP ? P.in[0] + (size_t)mr[k] * DM : P.in[1] + (size_t)(mr[k] - MP) * DM); }
          f32x4 v[4][4];
#pragma unroll
          for (int k = 0; k < 4; ++k)
#pragma unroll
              for (int j = 0; j < 4; ++j) v[k][j] = ((const f32x4*)xr[k] + lane)[64 * j];
#pragma unroll
          for (int k = 0; k < 4; ++k) {
              float sq = 0.f;
#pragma unroll
              for (int j = 0; j < 4; ++j) sq += (v[k][j][0] * v[k][j][0] + v[k][j][1] * v[k][j][1]) + (v[k][j][2] * v[k][j][2] + v[k][j][3] * v[k][j][3]);
              sq = wave_sum(sq);
              if (ok[k]) {
                  u32x2* o = (u32x2*)(xb + (size_t)mr[k] * DM) + lane;
#pragma unroll
                  for (int j = 0; j < 4; ++j) { u32x2 w; w.x = cvtpk(v[k][j][0], v[k][j][1]); w.y = cvtpk(v[k][j][2], v[k][j][3]); o[64 * j] = w; }
                  if (lane < 4) { const f32x4 z = {lane == 0 ? sq : 0.f, 0.f, 0.f, 0.f}; *(f32x4*)(st + (size_t)mr[k] * 16 + 4 * lane) = z; }
              }
          }
      } }
}

constexpr int AT_TILE = 64 * 256;
constexpr int AT_K0 = 0, AT_V0 = 3 * AT_TILE, AT_TAB = 7 * AT_TILE;
static_assert(AT_TAB + 260 * 4 <= 131072, "attention LDS");

__device__ __forceinline__ int t5_bucket(int rel) {
    int b = rel > 0 ? 16 : 0; const int n = rel < 0 ? -rel : rel;
    if (n < 8) return b + n;
    const float nf = (float)n;
    int large = 8 + (int)(logf(nf / 8.0f) / 2.772588722239781f * 8.0f);
    large = large < 15 ? large : 15;
    return b + large;
}
#define AT_TR(dst, addr, OFF) asm volatile("ds_read_b64_tr_b16 %0, %1 offset:%2" : "=&v"(dst) : "v"(addr), "i"(OFF))

__device__ __forceinline__ void attn_pv(unsigned vaddr, const int (&vo)[8], const bf16x8 (&pf)[2][2], f32x4 (&o)[2][8], f32x4 (&ol)[2]) {
    s16x4 r[3][4];
#define AT_TR4(slot, d) do { const unsigned _a = vaddr + (unsigned)vo[d]; AT_TR(r[slot][0], _a, 0); AT_TR(r[slot][1], _a, 16 * 256); AT_TR(r[slot][2], _a, 32 * 256); AT_TR(r[slot][3], _a, 48 * 256); } while (0)
    AT_TR4(0, 0); AT_TR4(1, 1);
    { const bf16x8 ones = (bf16x8){0x3f80, 0x3f80, 0x3f80, 0x3f80, 0x3f80, 0x3f80, 0x3f80, 0x3f80};
#pragma unroll
      for (int c = 0; c < 2; ++c)
#pragma unroll
          for (int si = 0; si < 2; ++si) ol[c] = __builtin_amdgcn_mfma_f32_16x16x32_bf16(ones, pf[c][si], ol[c], 0, 0, 0); }
#pragma unroll
    for (int dt = 0; dt < 8; ++dt) {
        const int cb = dt % 3;
        if (dt < 6) { AT_TR4((dt + 2) % 3, dt + 2); asm volatile("s_waitcnt lgkmcnt(8)" : "+v"(r[cb][0]), "+v"(r[cb][1]), "+v"(r[cb][2]), "+v"(r[cb][3])); }
        else if (dt == 6) asm volatile("s_waitcnt lgkmcnt(4)" : "+v"(r[cb][0]), "+v"(r[cb][1]), "+v"(r[cb][2]), "+v"(r[cb][3]));
        else asm volatile("s_waitcnt lgkmcnt(0)" : "+v"(r[cb][0]), "+v"(r[cb][1]), "+v"(r[cb][2]), "+v"(r[cb][3]));
#pragma unroll
        for (int si = 0; si < 2; ++si) {
            const s16x4 lo = r[cb][2 * si], hi = r[cb][2 * si + 1];
            const bf16x8 vf = (bf16x8){lo[0], lo[1], lo[2], lo[3], hi[0], hi[1], hi[2], hi[3]};
            o[0][dt] = __builtin_amdgcn_mfma_f32_16x16x32_bf16(vf, pf[0][si], o[0][dt], 0, 0, 0);
            o[1][dt] = __builtin_amdgcn_mfma_f32_16x16x32_bf16(vf, pf[1][si], o[1][dt], 0, 0, 0);
        }
    }
#undef AT_TR4
}

template <bool QK, bool PV>
__device__ __forceinline__ void attn_step(const LAS unsigned char* kbuf, unsigned vaddr, const int (&kfo)[2][2], const int (&vo)[8],
                                          const bf16x8 (&qf)[2][2], f32x4 (&s)[2][4], bf16x8 (&pf)[2][2], f32x4 (&o)[2][8], f32x4 (&ol)[2], const f32x4 (&tbv)[4]) {
    bf16x8 pn[2][2];
    s16x4 r[3][4];
#define AT_TR4(slot, d) do { const unsigned _a = vaddr + (unsigned)vo[d]; AT_TR(r[slot][0], _a, 0); AT_TR(r[slot][1], _a, 16 * 256); AT_TR(r[slot][2], _a, 32 * 256); AT_TR(r[slot][3], _a, 48 * 256); } while (0)
    if constexpr (PV) { AT_TR4(0, 0); AT_TR4(1, 1);
        const bf16x8 ones = (bf16x8){0x3f80, 0x3f80, 0x3f80, 0x3f80, 0x3f80, 0x3f80, 0x3f80, 0x3f80};
#pragma unroll
        for (int c = 0; c < 2; ++c)
#pragma unroll
            for (int si = 0; si < 2; ++si) ol[c] = __builtin_amdgcn_mfma_f32_16x16x32_bf16(ones, pf[c][si], ol[c], 0, 0, 0); }
#pragma unroll
    for (int dt = 0; dt < 8; ++dt) {
        if constexpr (PV) {
            const int cb = dt % 3;
            if (dt < 6) { AT_TR4((dt + 2) % 3, dt + 2); asm volatile("s_waitcnt lgkmcnt(8)" : "+v"(r[cb][0]), "+v"(r[cb][1]), "+v"(r[cb][2]), "+v"(r[cb][3])); }
            else if (dt == 6) asm volatile("s_waitcnt lgkmcnt(4)" : "+v"(r[cb][0]), "+v"(r[cb][1]), "+v"(r[cb][2]), "+v"(r[cb][3]));
            else asm volatile("s_waitcnt lgkmcnt(0)" : "+v"(r[cb][0]), "+v"(r[cb][1]), "+v"(r[cb][2]), "+v"(r[cb][3]));
#pragma unroll
            for (int si = 0; si < 2; ++si) {
                const s16x4 lo = r[cb][2 * si], hi = r[cb][2 * si + 1];
                const bf16x8 vf = (bf16x8){lo[0], lo[1], lo[2], lo[3], hi[0], hi[1], hi[2], hi[3]};
                o[0][dt] = __builtin_amdgcn_mfma_f32_16x16x32_bf16(vf, pf[0][si], o[0][dt], 0, 0, 0);
                o[1][dt] = __builtin_amdgcn_mfma_f32_16x16x32_bf16(vf, pf[1][si], o[1][dt], 0, 0, 0);
            }
        }
        {
            const int c = dt >> 2, kt = dt & 3;
#pragma unroll
            for (int j = 0; j < 4; ++j) s[c][kt][j] = fast_exp2(s[c][kt][j]);
            if (kt & 1) { const int si = kt >> 1;
                u32x4 wv; wv.x = cvtpk(s[c][2 * si][0], s[c][2 * si][1]); wv.y = cvtpk(s[c][2 * si][2], s[c][2 * si][3]);
                wv.z = cvtpk(s[c][2 * si + 1][0], s[c][2 * si + 1][1]); wv.w = cvtpk(s[c][2 * si + 1][2], s[c][2 * si + 1][3]);
                pn[c][si] = __builtin_bit_cast(bf16x8, wv); }
        }
    }
#undef AT_TR4
#pragma unroll
    for (int c = 0; c < 2; ++c)
#pragma unroll
        for (int si = 0; si < 2; ++si) pf[c][si] = pn[c][si];
    if constexpr (QK) {
#pragma unroll
        for (int kt = 0; kt < 4; ++kt)
#pragma unroll
            for (int c = 0; c < 2; ++c) {
                f32x4 a = tbv[kt];
#pragma unroll
                for (int kk = 0; kk < 2; ++kk) { const bf16x8 kf = *(const LAS bf16x8*)(kbuf + kfo[c][kk] + kt * 4096); a = __builtin_amdgcn_mfma_f32_16x16x32_bf16(kf, qf[c][kk], a, 0, 0, 0); }
                s[c][kt] = a;
            }
    }
}

__device__ __forceinline__ void attn_unit(LAS unsigned char* lds, int seq, int h, int qb, bf16_t* UQ, const bf16_t* KB, const bf16_t* VB, const float* rel_bias, const float* subln, float lam, float bmax) {
    const int tid = threadIdx.x, lane = tid & 63, w = __builtin_amdgcn_readfirstlane(tid >> 6), r16 = lane & 15, fq = lane >> 4;
    int row0, S; if (seq < NSEQ_P) { row0 = seq * SEQ_P; S = SEQ_P; } else { row0 = MP + (seq - NSEQ_P) * SEQ_S; S = SEQ_S; }
    const int q0 = qb * 128, NT = S / 64, tmask = NT - 1, tstart = 2 * qb;
    const LAS unsigned char* tab = lds + AT_TAB;
    const unsigned lds0 = (unsigned)(size_t)lds;
    if (tid < 257) ((LAS float*)(lds + AT_TAB))[tid] = LOG2E * (rel_bias[t5_bucket(tid - 128) * 4 + h] - bmax);
    bf16x8 qf[2][2];
    { const bf16_t* qp = UQ + (size_t)(row0 + q0 + 16 * w + r16) * DM + 512 + 128 * h + 8 * fq;
#pragma unroll
      for (int c = 0; c < 2; ++c)
#pragma unroll
          for (int kk = 0; kk < 2; ++kk) qf[c][kk] = *(const bf16x8*)(qp + 64 * c + 32 * kk); }
    f32x4 o[2][8];
#pragma unroll
    for (int c = 0; c < 2; ++c)
#pragma unroll
        for (int d = 0; d < 8; ++d) o[c][d] = (f32x4){0.f, 0.f, 0.f, 0.f};
    f32x4 ol[2] = {(f32x4){0.f, 0.f, 0.f, 0.f}, (f32x4){0.f, 0.f, 0.f, 0.f}};
    unsigned kso[2], vso[2];
#pragma unroll
    for (int i = 0; i < 2; ++i) { const int row = 4 * (2 * w + i) + (lane >> 4), pos = lane & 15;
        kso[i] = (unsigned)(row * 512 + 8 * (pos ^ (row & 15))) * 2u; vso[i] = (unsigned)(row * 512 + 8 * (pos ^ (2 * (row & 7)))) * 2u; }
    const char* kg = (const char*)(KB + (size_t)row0 * 512 + 128 * h);
    const char* vg = (const char*)(VB + (size_t)row0 * 512 + 128 * h);
#define AT_STAGE(gbase, so, i, ldsoff) do { const int _ii = (i) < NT ? (i) : NT - 1; const size_t _go = (size_t)((tstart + _ii) & tmask) * (64 * 1024); _Pragma("unroll") for (int _i = 0; _i < 2; ++_i) \
        __builtin_amdgcn_global_load_lds((const unsigned*)((gbase) + _go + (so)[_i]), (LAS unsigned*)(lds + (ldsoff) + (2 * w + _i) * 1024), 16, 0, 0); } while (0)
#define AT_BAR(N) asm volatile("s_waitcnt vmcnt(" #N ") lgkmcnt(0)\n\ts_barrier" ::: "memory")
    AT_STAGE(kg, kso, 0, AT_K0); AT_STAGE(vg, vso, 0, AT_V0); AT_STAGE(kg, kso, 1, AT_K0 + AT_TILE); AT_STAGE(vg, vso, 1, AT_V0 + AT_TILE); AT_STAGE(kg, kso, 2, AT_K0 + 2 * AT_TILE);
    int kfo[2][2], vo[8];
#pragma unroll
    for (int c = 0; c < 2; ++c)
#pragma unroll
        for (int kk = 0; kk < 2; ++kk) kfo[c][kk] = r16 * 256 + (((8 * c + 4 * kk + fq) ^ r16) * 16);
    { const int rk = 4 * (fq & 1) + (r16 >> 2);
#pragma unroll
      for (int dt = 0; dt < 8; ++dt) vo[dt] = (4 * fq + (r16 >> 2)) * 256 + ((dt ^ rk) * 32) + (r16 & 3) * 8; }
    const int qrow = q0 + 16 * w;
    const int tixb = (4 * fq - (qrow + r16) + 128) * 4;
    f32x4 s[2][4]; bf16x8 pf[2][2];
#pragma unroll
    for (int c = 0; c < 2; ++c)
#pragma unroll
        for (int si = 0; si < 2; ++si) pf[c][si] = (bf16x8){0, 0, 0, 0, 0, 0, 0, 0};
    AT_BAR(0);
    const float tbL = *(const LAS float*)(tab), tbR = *(const LAS float*)(tab + 1024);
    f32x4 tbv[4];
#define AT_TB(jt) do { const int _k0 = (jt) * 64; const int _rmax = _k0 + 63 - qrow, _rmin = _k0 - (qrow + 15); \
        if (_rmax <= -128 || _rmin >= 128) { const float _t = _rmin >= 128 ? tbR : tbL; _Pragma("unroll") for (int _kt = 0; _kt < 4; ++_kt) tbv[_kt] = (f32x4){_t, _t, _t, _t}; } \
        else { _Pragma("unroll") for (int _kt = 0; _kt < 4; ++_kt) _Pragma("unroll") for (int _j = 0; _j < 4; ++_j) { int _ix = tixb + 256 * (jt) + (16 * _kt + _j) * 4; _ix = _ix < 0 ? 0 : (_ix > 1024 ? 1024 : _ix); tbv[_kt][_j] = *(const LAS float*)(tab + _ix); } } } while (0)
    AT_TB(tstart & tmask);
#pragma unroll
    for (int kt = 0; kt < 4; ++kt) {
#pragma unroll
        for (int c = 0; c < 2; ++c) {
            f32x4 a = tbv[kt];
#pragma unroll
            for (int kk = 0; kk < 2; ++kk) { const bf16x8 kf = *(const LAS bf16x8*)(lds + AT_K0 + kfo[c][kk] + kt * 4096); a = __builtin_amdgcn_mfma_f32_16x16x32_bf16(kf, qf[c][kk], a, 0, 0, 0); }
            s[c][kt] = a;
        }
    }
    AT_BAR(0);
    AT_STAGE(kg, kso, 3, AT_K0); AT_STAGE(vg, vso, 2, AT_V0 + 2 * AT_TILE);
    AT_TB((tstart + 1) & tmask);
    attn_step<true, false>(lds + AT_K0 + AT_TILE, 0u, kfo, vo, qf, s, pf, o, ol, tbv);
    AT_BAR(4);
    int k_i = AT_K0 + AT_TILE, k_n = AT_K0 + 2 * AT_TILE, k_p = AT_K0;
    for (int i = 1; i < NT - 1; ++i) {
        AT_STAGE(kg, kso, i + 3, k_i); AT_STAGE(vg, vso, i + 2, AT_V0 + ((i + 2) & 3) * AT_TILE);
        AT_TB((tstart + i + 1) & tmask);
        attn_step<true, true>(lds + k_n, lds0 + AT_V0 + ((i - 1) & 3) * AT_TILE, kfo, vo, qf, s, pf, o, ol, tbv);
        AT_BAR(4);
        { const int tmp = k_i; k_i = k_n; k_n = k_p; k_p = tmp; }
    }
    attn_step<false, true>(lds, lds0 + AT_V0 + ((NT - 2) & 3) * AT_TILE, kfo, vo, qf, s, pf, o, ol, tbv);
    attn_pv(lds0 + AT_V0 + ((NT - 1) & 3) * AT_TILE, vo, pf, o, ol);
#undef AT_STAGE
    const float i0 = 1.0f / ol[0][0], i1 = lam / ol[1][0];
    float ss = 0.f;
#pragma unroll
    for (int dt = 0; dt < 8; ++dt)
#pragma unroll
        for (int j = 0; j < 4; ++j) { const float v = o[0][dt][j] * i0 - o[1][dt][j] * i1; o[0][dt][j] = v; ss += v * v; }
    ss += __shfl_xor(ss, 16); ss += __shfl_xor(ss, 32);
    const float rs = __builtin_amdgcn_rsqf(ss * (1.0f / 128.0f) + EPS) * 0.8f;
    bf16_t* op = UQ + (size_t)(row0 + q0 + 16 * w + r16) * DM + 512 + 128 * h + 4 * fq;
#pragma unroll
    for (int dt = 0; dt < 8; ++dt) {
        const f32x4 gsl = *(const f32x4*)(subln + 16 * dt + 4 * fq);
        u32x2 wv; wv.x = cvtpk(o[0][dt][0] * rs * gsl[0], o[0][dt][1] * rs * gsl[1]); wv.y = cvtpk(o[0][dt][2] * rs * gsl[2], o[0][dt][3] * rs * gsl[3]);
        *(u32x2*)(op + 16 * dt) = wv;
    }
    AT_BAR(0);
#undef AT_BAR
#undef AT_TB
}

__device__ __forceinline__ s16x4 tr_read(const LAS unsigned char* p) { return __builtin_bit_cast(s16x4, __builtin_amdgcn_ds_read_tr16_b64_v4i16((LAS s16x4*)p)); }
constexpr int SG_P = 144, SG_TILE = 128 * SG_P;
__device__ __forceinline__ void sgu_unit(LAS unsigned char* lds, int x, bf16_t* UQ, const bf16_t* VA, const float* stv, const float* sgn, const bf16_t* SW, const float* sgb) {
    const int tid = threadIdx.x, lane = tid & 63, w = __builtin_amdgcn_readfirstlane(tid >> 6), r16 = lane & 15, fq = lane >> 4;
    const int chunk = x >> 1, half = x & 1, r0 = chunk * 128;
#pragma unroll
    for (int i = 0; i < 8; ++i) {
        const int id = tid + 512 * i, s = id >> 5, ch = id & 31, g2 = ch >> 3, d8 = ch & 7;
        const u32x4 v = *(const u32x4*)(VA + (size_t)(r0 + s) * 512 + 256 * half + 8 * ch);
        const float rs = rstd_from(stv, r0 + s, 8, 1.0f / 512.0f);
        const f32x4 g0 = *(const f32x4*)(sgn + 256 * half + 8 * ch), g1 = *(const f32x4*)(sgn + 256 * half + 8 * ch + 4);
        u32x4 o; o.x = cvtpk(bflo(v.x) * rs * g0[0], bfhi(v.x) * rs * g0[1]); o.y = cvtpk(bflo(v.y) * rs * g0[2], bfhi(v.y) * rs * g0[3]);
        o.z = cvtpk(bflo(v.z) * rs * g1[0], bfhi(v.z) * rs * g1[1]); o.w = cvtpk(bflo(v.w) * rs * g1[2], bfhi(v.w) * rs * g1[3]);
        *(LAS u32x4*)(lds + g2 * SG_TILE + s * SG_P + d8 * 16) = o;
    }
    __syncthreads();
    const int g2 = w & 3, th = w >> 2, g = 4 * half + g2;
    const LAS unsigned char* tb = lds + g2 * SG_TILE + (4 * fq + (r16 >> 2)) * SG_P + (r16 & 3) * 8;
    bf16x8 af[4][4];
#pragma unroll
    for (int dt = 0; dt < 4; ++dt)
#pragma unroll
        for (int ks = 0; ks < 4; ++ks) { const s16x4 lo = tr_read(tb + (32 * ks) * SG_P + dt * 32), hi = tr_read(tb + (32 * ks + 16) * SG_P + dt * 32);
            af[dt][ks] = (bf16x8){lo[0], lo[1], lo[2], lo[3], hi[0], hi[1], hi[2], hi[3]}; }
#pragma unroll
    for (int tt = 0; tt < 4; ++tt) {
        const int t = 64 * th + 16 * tt + r16;
        bf16x8 bfr[4];
#pragma unroll
        for (int ks = 0; ks < 4; ++ks) bfr[ks] = *(const bf16x8*)(SW + ((size_t)(g * 128 + t) * 128 + 32 * ks + 8 * fq));
        const float bt = sgb[g * 128 + t];
        bf16_t* up = UQ + (size_t)(r0 + t) * DM + 64 * g + 4 * fq;
#pragma unroll
        for (int dt = 0; dt < 4; ++dt) {
            f32x4 a = (f32x4){0.f, 0.f, 0.f, 0.f};
#pragma unroll
            for (int ks = 0; ks < 4; ++ks) a = __builtin_amdgcn_mfma_f32_16x16x32_bf16(af[dt][ks], bfr[ks], a, 0, 0, 0);
            const u32x2 uv = *(const u32x2*)(up + 16 * dt);
            u32x2 wv; wv.x = cvtpk(bflo(uv.x) * (a[0] + bt), bfhi(uv.x) * (a[1] + bt)); wv.y = cvtpk(bflo(uv.y) * (a[2] + bt), bfhi(uv.y) * (a[3] + bt));
            *(u32x2*)(up + 16 * dt) = wv;
        }
    }
    __syncthreads();
}

#define XB_TMO      128
#define XB_XCNT(j)  (256  + 64 * (j))
#define XB_XSUB(j)  (1280 + 64 * (j))
#define XB_XGEN(j)  (2304 + 64 * (j))
#define XB_TOP      3328
#define XB_TOPGEN   3392
#define XCD_BAR_WORDS 3456
#define XB_SPIN_CAP (1u << 18)
__device__ __forceinline__ unsigned xb_ld(unsigned* p)              { return __hip_atomic_load(p, __ATOMIC_RELAXED, __HIP_MEMORY_SCOPE_AGENT); }
__device__ __forceinline__ unsigned xb_add(unsigned* p, unsigned v) { return __hip_atomic_fetch_add(p, v, __ATOMIC_RELAXED, __HIP_MEMORY_SCOPE_AGENT); }
__device__ __forceinline__ unsigned xb_xcc_id() { return (unsigned)__builtin_amdgcn_s_getreg((3 << 11) | 20) & 0xFu; }
#define XB_SPIN(cond, bar) do { unsigned _sp = 0; while (cond) { __builtin_amdgcn_s_sleep(1); \
    if ((++_sp & 255u) == 0u) { if (xb_ld(&(bar)[XB_TMO])) break; if (_sp > XB_SPIN_CAP) { atomicAdd(&(bar)[XB_TMO], 1u); break; } } } } while (0)
struct XcdBarrier { unsigned* bar; unsigned x; volatile LAS unsigned* st; };
__device__ __forceinline__ XcdBarrier xcd_barrier_post(unsigned* bar, volatile LAS unsigned* st) {
    XcdBarrier b; b.bar = bar; b.x = xb_xcc_id(); b.st = st;
    if (threadIdx.x == 0) (void)xb_add(&bar[XB_XCNT(b.x)], 1u);
    return b;
}
__device__ __forceinline__ void xcd_barrier_complete(unsigned* bar, unsigned x, unsigned& nloc, unsigned& nx) {
    const unsigned G = gridDim.x * gridDim.y * gridDim.z;
    unsigned sum, cnt, mine, sp = 0u;
    for (;;) {
        sum = 0u; cnt = 0u; mine = 0u;
#pragma unroll
        for (unsigned j = 0; j < 16; ++j) { const unsigned c = xb_ld(&bar[XB_XCNT(j)]); sum += c; cnt += (c > 0u) ? 1u : 0u; mine = (j == x) ? c : mine; }
        if (sum == G) break;
        __builtin_amdgcn_s_sleep(1);
        if ((++sp & 255u) == 0u) { if (xb_ld(&bar[XB_TMO])) break; if (sp > XB_SPIN_CAP) { atomicAdd(&bar[XB_TMO], 1u); break; } }
    }
    nloc = mine > 0u ? mine : 1u; nx = cnt > 0u ? cnt : 1u;
}
__device__ __forceinline__ void xcd_barrier(const XcdBarrier& b) {
    asm volatile("s_waitcnt vmcnt(0)" ::: "memory");
    __syncthreads();
    if (threadIdx.x == 0) {
        unsigned* bar = b.bar;
        __builtin_amdgcn_s_waitcnt(0);
        unsigned nloc = b.st[0], nx = b.st[1];
        if (nloc == 0u) { xcd_barrier_complete(bar, b.x, nloc, nx); b.st[0] = nloc; b.st[1] = nx; }
        const unsigned old = xb_add(&bar[XB_XSUB(b.x)], 1u);
        const unsigned gen = old / nloc;
        if (old + 1u == (gen + 1u) * nloc) {
            __builtin_amdgcn_fence(__ATOMIC_RELEASE, "agent");
            asm volatile("s_waitcnt vmcnt(0)" ::: "memory");
            const unsigned og = xb_add(&bar[XB_TOP], 1u);
            const unsigned tg = og / nx;
            if (og + 1u == (tg + 1u) * nx) xb_add(&bar[XB_TOPGEN], 1u);
            else XB_SPIN(xb_ld(&bar[XB_TOPGEN]) == tg, bar);
            __builtin_amdgcn_fence(__ATOMIC_ACQUIRE, "agent");
            xb_add(&bar[XB_XGEN(b.x)], 1u);
            asm volatile("s_waitcnt vmcnt(0)" ::: "memory");
        } else {
            XB_SPIN(xb_ld(&bar[XB_XGEN(b.x)]) == gen, bar);
            __builtin_amdgcn_fence(__ATOMIC_ACQUIRE, "agent");
            asm volatile("s_waitcnt vmcnt(0)" ::: "memory");
        }
    }
    __syncthreads();
}

constexpr int N_PHASES = 11;
__global__ void __launch_bounds__(512, 2) fwd_megakernel(Params P) {
    extern __shared__ __attribute__((aligned(16))) unsigned char lds_raw[];
    LAS unsigned char* lds = (LAS unsigned char*)lds_raw;
    cg::grid_group grid = cg::this_grid();
    const int tid = threadIdx.x, lane = tid & 63, wave = __builtin_amdgcn_readfirstlane(tid >> 6);
    const int G = gridDim.x, bx = blockIdx.x, vcu = (G % 8 == 0) ? (bx % 8) * (G / 8) + bx / 8 : bx;
    unsigned char* ws = P.ws;
    const int lo = P.ph_lo, hi = P.ph_hi;
#define IN(k) (lo <= (k) && (k) < hi)
#define SEAM(k) do { if (IN(k) && IN((k) + 1)) { if (hi == 0x7fffffff) grid.sync(); else xcd_barrier(bar); } } while (0)
    volatile LAS unsigned* MISC = (volatile LAS unsigned*)(lds + MISC_OFF);
    if (tid < 16) MISC[tid] = 0u;
    __syncthreads();
    XcdBarrier bar; bar.bar = (unsigned*)(ws + WS_CTL); bar.x = 0; bar.st = MISC + 8;
    if (hi - lo > 1) bar = xcd_barrier_post((unsigned*)(ws + WS_CTL), MISC + 8);
    float* STA = (float*)(ws + WS_STA); float* STV = (float*)(ws + WS_STV);
    bf16_t* XB = (bf16_t*)(ws + WS_XB); bf16_t* UQ = (bf16_t*)(ws + WS_UQ); bf16_t* ACT = (bf16_t*)(ws + WS_ACT);

    if (IN(0)) { prologue(P, lds, vcu * 8 + wave, G * 8, wave, lane); }
    SEAM(0);
    if (IN(1)) {
        pg8::Gemm g{XB, (const bf16_t*)(ws + WS_W1IN), MT, 2 * DFF, DM}; pg8::StaticOrder S; S.init(MT, 2 * DFF, G, bx);
        EpiSwiGLU E{ACT, STA}; pg8::gemm_phase(lds, g, S, E);
    }
    SEAM(1);
    if (IN(2)) {
        pg8::Gemm g{ACT, (const bf16_t*)(ws + WS_W1OUT), MT, DM, DFF}; pg8::StaticOrder S; S.init(MT, DM, G, bx);
        EpiRes<true, false> E{nullptr, nullptr, XB, nullptr, XB, STA, 0.5f}; pg8::gemm_phase(lds, g, S, E);
    }
    SEAM(2);
    if (IN(3)) {
        pg8::Gemm g{XB, (const bf16_t*)(ws + WS_WIN), MT, NA1, DM}; pg8::StaticOrder S; S.init(MT, NA1, G, bx);
        EpiMixA E{UQ, (bf16_t*)(ws + WS_VA), (bf16_t*)(ws + WS_KB), (bf16_t*)(ws + WS_VB), STA, STV, P.in[12], P.in[13]}; pg8::gemm_phase(lds, g, S, E);
    }
    SEAM(3);
    if (IN(4)) {
        const float d1 = wave_sum(P.in[14][lane] * P.in[15][lane]), d2 = wave_sum(P.in[16][lane] * P.in[17][lane]);
        const float lam = expf(d1) - expf(d2) + 0.2f;
        float mq = fabsf(P.in[12][lane]), mk = fabsf(P.in[13][lane]), mb = fmaxf(P.in[2][lane], P.in[2][64 + lane]);
#pragma unroll
        for (int o = 1; o < 64; o <<= 1) { mq = fmaxf(mq, __shfl_xor(mq, o)); mk = fmaxf(mk, __shfl_xor(mk, o)); mb = fmaxf(mb, __shfl_xor(mb, o)); }
        const float bmax = 8.0f * mq * mk + mb;
        const bf16_t* KB = (const bf16_t*)(ws + WS_KB); const bf16_t* VB = (const bf16_t*)(ws + WS_VB);
        for (int i = vcu; i < NSEQ_S * 4 * 32; i += G) { const int sh = i >> 5, qb = i & 31; attn_unit(lds, NSEQ_P + (sh >> 2), sh & 3, qb, UQ, KB, VB, P.in[2], P.in[18], lam, bmax); }
        for (int i = vcu; i < NSEQ_P * 4 * 16; i += G) { const int sh = i >> 4, qb = i & 15; attn_unit(lds, sh >> 2, sh & 3, qb, UQ, KB, VB, P.in[2], P.in[18], lam, bmax); }
        for (int x = vcu; x < (MT / 128) * 2; x += G) sgu_unit(lds, x, UQ, (const bf16_t*)(ws + WS_VA), STV, P.in[9], (const bf16_t*)(ws + WS_SGUW), P.in[11]);
    }
    SEAM(4);
    if (IN(5)) {
        pg8::Gemm g{XB, (const bf16_t*)(ws + WS_WIN) + (size_t)NA1 * DM, MT, NG, DM}; pg8::StaticOrder S; S.init(MT, NG, G, bx);
        EpiGate E{(bf16_t*)(ws + WS_GA), (bf16_t*)(ws + WS_GB), STA, P.in[8]}; pg8::gemm_phase(lds, g, S, E);
    }
    SEAM(5);
    if (IN(6)) {
        pg8::Gemm g{UQ, (const bf16_t*)(ws + WS_WP), MT, DM, DM}; pg8::StaticOrder S; S.init(MT, DM, G, bx);
        EpiMerge E{(const bf16_t*)(ws + WS_GA), (const bf16_t*)(ws + WS_GB), (bf16_t*)(ws + WS_MG)}; pg8::gemm_phase(lds, g, S, E);
    }
    SEAM(6);
    if (IN(7)) {
        pg8::Gemm g{(const bf16_t*)(ws + WS_MG), (const bf16_t*)(ws + WS_WO), MT, DM, DM}; pg8::StaticOrder S; S.init(MT, DM, G, bx);
        EpiRes<true, false> E{nullptr, nullptr, XB, nullptr, (bf16_t*)(ws + WS_XB2), STA, 1.0f}; pg8::gemm_phase(lds, g, S, E);
    }
    SEAM(7);
    if (IN(8)) {
        pg8::Gemm g{(const bf16_t*)(ws + WS_XB2), (const bf16_t*)(ws + WS_W2IN), MT, 2 * DFF, DM}; pg8::StaticOrder S; S.init(MT, 2 * DFF, G, bx);
        EpiSwiGLU E{ACT, STA}; pg8::gemm_phase(lds, g, S, E);
    }
    SEAM(8);
    if (IN(9)) {
        pg8::Gemm g{ACT, (const bf16_t*)(ws + WS_W2OUT), MT, DM, DFF}; pg8::StaticOrder S; S.init(MT, DM, G, bx);
        EpiRes<true, false> E{nullptr, nullptr, (const bf16_t*)(ws + WS_XB2), nullptr, XB, STA, 0.5f}; pg8::gemm_phase(lds, g, S, E);
    }
    SEAM(9);
    if (IN(10)) {
        const float* fn = P.in[25];
        f32x4 gv[4];
#pragma unroll
        for (int j = 0; j < 4; ++j) gv[j] = ((const f32x4*)fn)[lane + 64 * j];
        for (int m = vcu * 8 + wave; m < MT; m += G * 16) {
            const int m1 = m + G * 8; const bool has1 = m1 < MT; const int mb = has1 ? m1 : m;
            const float rs0 = rstd_from(STA, m, 16, 1.0f / 1024.0f), rs1 = rstd_from(STA, mb, 16, 1.0f / 1024.0f);
            const u32x2* s0 = (const u32x2*)(XB + (size_t)m * DM) + lane; const u32x2* s1 = (const u32x2*)(XB + (size_t)mb * DM) + lane;
            u32x2 v0[4], v1[4];
#pragma unroll
            for (int j = 0; j < 4; ++j) { v0[j] = s0[64 * j]; v1[j] = s1[64 * j]; }
            f32x4* x40 = (f32x4*)(P.out + (size_t)m * DM) + lane; f32x4* x41 = (f32x4*)(P.out + (size_t)mb * DM) + lane;
#pragma unroll
            for (int j = 0; j < 4; ++j) x40[64 * j] = (f32x4){bflo(v0[j].x), bfhi(v0[j].x), bflo(v0[j].y), bfhi(v0[j].y)} * gv[j] * rs0;
            if (has1) {
#pragma unroll
                for (int j = 0; j < 4; ++j) x41[64 * j] = (f32x4){bflo(v1[j].x), bfhi(v1[j].x), bflo(v1[j].y), bfhi(v1[j].y)} * gv[j] * rs1;
            }
        }
    }
#undef IN
#undef SEAM
}

#ifndef MK_SPLIT
#define MK_SPLIT 0
#endif
extern "C" void kernel_launch(void* const* d_in, const int* in_sizes, int n_in, void* d_out, int out_size, void* d_ws, size_t ws_size, hipStream_t stream) {
    static int grid = 0;
    if (grid == 0) {
        if (n_in != 26 || out_size != MT * DM || ws_size < WS_CTL + CTL_BYTES) { fprintf(stderr, "kernel_launch: unexpected shapes: n_in %d out %d ws %zu (need %zu)\n", n_in, out_size, ws_size, (size_t)WS_END); grid = -1; return; }
        int dev = 0, cus = 0, per_cu = 0;
        hipGetDevice(&dev); hipDeviceGetAttribute(&cus, hipDeviceAttributeMultiprocessorCount, dev);
        if (hipFuncSetAttribute((const void*)fwd_megakernel, hipFuncAttributeMaxDynamicSharedMemorySize, LDS_BYTES) != hipSuccess) { fprintf(stderr, "kernel_launch: hipFuncSetAttribute failed\n"); grid = -1; return; }
        if (hipOccupancyMaxActiveBlocksPerMultiprocessor(&per_cu, (const void*)fwd_megakernel, 512, LDS_BYTES) != hipSuccess || per_cu < 1) { fprintf(stderr, "kernel_launch: occupancy query says %d\n", per_cu); per_cu = 1; }
        (void)hipGetLastError();
        grid = cus * 1;
    }
    if (grid < 0) return;
    Params p{};
    for (int i = 0; i < 26; ++i) p.in[i] = (const float*)d_in[i];
    p.out = (float*)d_out; p.ws = (unsigned char*)d_ws;
#if MK_SPLIT
    for (int k = 0; k < N_PHASES; ++k) { p.ph_lo = k; p.ph_hi = k + 1; hipLaunchKernelGGL(fwd_megakernel, dim3(grid), dim3(512), LDS_BYTES, stream, p); }
#else
    p.ph_lo = 0; p.ph_hi = N_PHASES;
    if (hipMemsetAsync((char*)d_ws + WS_CTL, 0, CTL_BYTES, stream) != hipSuccess) { fprintf(stderr, "kernel_launch: memset of the barrier words failed\n"); return; }
    void* args[] = {&p};
    hipError_t e = hipLaunchCooperativeKernel((const void*)fwd_megakernel, dim3(grid), dim3(512), args, LDS_BYTES, stream);
    if (e != hipSuccess) fprintf(stderr, "kernel_launch: cooperative launch failed: %s (grid %d)\n", hipGetErrorString(e), grid);
#endif
}
```

```cpp
#include <hip/hip_runtime.h>
#include <hip/hip_cooperative_groups.h>
#include <cstdio>
#include <cstdint>
namespace cg = cooperative_groups;

#define LAS __attribute__((address_space(3)))
typedef unsigned short bf16_t;
typedef short bf16x8 __attribute__((ext_vector_type(8)));
typedef short s16x4 __attribute__((ext_vector_type(4)));
typedef float f32x4 __attribute__((ext_vector_type(4)));
typedef float f32x2 __attribute__((ext_vector_type(2)));
typedef unsigned u32x4 __attribute__((ext_vector_type(4)));
typedef unsigned u32x2 __attribute__((ext_vector_type(2)));
typedef __bf16 bf16x2_t __attribute__((ext_vector_type(2)));

constexpr int DM = 1024, DFF = 2816, MP = 32768, MS = 16384, MT = MP + MS;
constexpr int NSEQ_P = 16, SEQ_P = 2048, NSEQ_S = 4, SEQ_S = 4096;
constexpr int NA1 = 2560, NG = 2048, NIN = NA1 + NG;
constexpr float EPS = 1e-6f;
constexpr float LOG2E = 1.4426950408889634f;
constexpr float QSCALE = 0.125f * LOG2E;

constexpr size_t MiB = 1u << 20;
constexpr size_t WS_STA = 0, WS_STV = 3 * MiB;
constexpr size_t WS_W1IN = 6 * MiB;
constexpr size_t WS_W1OUT = WS_W1IN + (size_t)5632 * 1024 * 2;
constexpr size_t WS_WIN = WS_W1OUT + (size_t)1024 * 2816 * 2;
constexpr size_t WS_WP = WS_WIN + (size_t)4608 * 1024 * 2;
constexpr size_t WS_WO = WS_WP + (size_t)1024 * 1024 * 2;
constexpr size_t WS_W2IN = WS_WO + (size_t)1024 * 1024 * 2;
constexpr size_t WS_W2OUT = WS_W2IN + (size_t)5632 * 1024 * 2;
constexpr size_t WS_SGUW = WS_W2OUT + (size_t)1024 * 2816 * 2;
constexpr size_t WS_R = 53 * MiB;
static_assert(WS_SGUW + 8 * 128 * 128 * 2 <= WS_R, "weights fit");
constexpr size_t WS_XB = WS_R;
constexpr size_t WS_MG = WS_R + 192 * MiB;
constexpr size_t WS_UQ = WS_R + 96 * MiB;
constexpr size_t WS_XB2 = WS_UQ;
constexpr size_t WS_VA = WS_R + 192 * MiB;
constexpr size_t WS_KB = WS_R + 240 * MiB;
constexpr size_t WS_VB = WS_R + 288 * MiB;
constexpr size_t WS_GA = WS_R + 192 * MiB;
constexpr size_t WS_GB = WS_R + 288 * MiB;
constexpr size_t WS_ACT = WS_R + 192 * MiB;
constexpr size_t WS_END = WS_ACT + (size_t)MT * DFF * 2;
constexpr size_t WS_CTL = WS_END, CTL_BYTES = 16384;
static_assert(WS_CTL + CTL_BYTES <= 512 * MiB, "workspace");
constexpr int MISC_OFF = 131072;

constexpr int LDS_BYTES = 155648;
constexpr int STAB_OFF = 131072 + 1024;

__device__ __forceinline__ unsigned cvtpk(float lo, float hi) { f32x2 v = {lo, hi}; bf16x2_t b = __builtin_convertvector(v, bf16x2_t); return __builtin_bit_cast(unsigned, b); }
__device__ __forceinline__ float bflo(unsigned w) { return __uint_as_float(w << 16); }
__device__ __forceinline__ float bfhi(unsigned w) { return __uint_as_float(w & 0xffff0000u); }
__device__ __forceinline__ float fast_rcp(float x) { return __builtin_amdgcn_rcpf(x); }
__device__ __forceinline__ float fast_exp2(float x) { return __builtin_amdgcn_exp2f(x); }
__device__ __forceinline__ float sigmoidf_(float x) { return fast_rcp(1.0f + fast_exp2(-LOG2E * x)); }
__device__ __forceinline__ float siluf_(float x) { return x * sigmoidf_(x); }
__device__ __forceinline__ float gelu_tanh(float x) { const float z = x + 0.044715f * x * x * x; return x * fast_rcp(1.0f + fast_exp2((-2.0f * 0.7978845608028654f * LOG2E) * z)); }
__device__ __forceinline__ f32x4 exp2_4(f32x4 t) { return (f32x4){fast_exp2(t[0]), fast_exp2(t[1]), fast_exp2(t[2]), fast_exp2(t[3])}; }
__device__ __forceinline__ f32x4 rcp_4(f32x4 t) { return (f32x4){fast_rcp(t[0]), fast_rcp(t[1]), fast_rcp(t[2]), fast_rcp(t[3])}; }
__device__ __forceinline__ f32x4 sig_from_negl2(f32x4 t) { return rcp_4(exp2_4(t) + 1.0f); }
__device__ __forceinline__ u32x2 pack4(f32x4 v) { u32x2 w; w.x = cvtpk(v[0], v[1]); w.y = cvtpk(v[2], v[3]); return w; }
__device__ __forceinline__ float wave_sum(float v) {
#pragma unroll
    for (int o = 1; o < 64; o <<= 1) v += __shfl_xor(v, o);
    return v;
}
__device__ __forceinline__ float rstd_from(const float* st, int row, int np, float inv_dim) {
    float s = 0.f;
    if (np == 1) s = st[(size_t)row * 16];
    else { const f32x4* p = (const f32x4*)(st + (size_t)row * 16);
#pragma unroll 4
        for (int i = 0; i < np / 4; ++i) { const f32x4 v = p[i]; s += (v[0] + v[1]) + (v[2] + v[3]); } }
    return __builtin_amdgcn_rsqf(s * inv_dim + EPS);
}


__device__ __forceinline__ void rstd8(const float* st, int rbase, int fq, float inv_dim, float (&rs)[2][4]) {
    f32x4 v[2][4];
#pragma unroll
    for (int ai = 0; ai < 2; ++ai)
#pragma unroll
        for (int m = 0; m < 4; ++m) v[ai][m] = *(const f32x4*)(st + (size_t)(rbase + ai * 128 + m * 16) * 16 + 4 * fq);
#pragma unroll
    for (int ai = 0; ai < 2; ++ai)
#pragma unroll
        for (int m = 0; m < 4; ++m) { float q = (v[ai][m][0] + v[ai][m][1]) + (v[ai][m][2] + v[ai][m][3]); q += __shfl_xor(q, 16); q += __shfl_xor(q, 32); rs[ai][m] = __builtin_amdgcn_rsqf(q * inv_dim + EPS); }
}

__device__ __forceinline__ void rstd8_lds(int rrel, int fq, float inv_dim, float (&rs)[2][4]) {
    const LAS unsigned char* lds = (const LAS unsigned char*)0;
    f32x4 v[2][4];
#pragma unroll
    for (int ai = 0; ai < 2; ++ai)
#pragma unroll
        for (int m = 0; m < 4; ++m) v[ai][m] = *(const LAS f32x4*)(lds + STAB_OFF + (rrel + ai * 128 + m * 16) * 64 + fq * 16);
#pragma unroll
    for (int ai = 0; ai < 2; ++ai)
#pragma unroll
        for (int m = 0; m < 4; ++m) { float q = (v[ai][m][0] + v[ai][m][1]) + (v[ai][m][2] + v[ai][m][3]); q += __shfl_xor(q, 16); q += __shfl_xor(q, 32); rs[ai][m] = __builtin_amdgcn_rsqf(q * inv_dim + EPS); }
}

namespace pg8 {
constexpr int BM = 256, BK = 64, HALF = 128, HTB = HALF * BK * 2, STAGE_BYTES = 8 * HTB, NXCD = 8, WGM = 8;
__host__ __device__ __forceinline__ int lds_byte(int r, int c) { const int st = (r >> 4) * 2 + (c >> 5), rr = r & 15, cc = c & 31, ob = rr * 64 + cc * 2; return st * 1024 + (ob ^ (((ob >> 9) & 1) << 5)); }
__host__ __device__ __forceinline__ void stage_rc(int b, int& R, int& C) { const int st = b / 1024, sb = b % 1024, swz = sb ^ (((sb >> 9) & 1) << 5); R = (st >> 1) * 16 + swz / 64; C = (st & 1) * 32 + (swz % 64) / 2; }
__host__ __device__ __forceinline__ int perm32(int rho) { const int n = rho >> 4, i = rho & 15; return 8 * (i >> 2) + 4 * n + (i & 3); }

struct Unit { int pm, pn; };
struct Gemm { const bf16_t* A; const bf16_t* Bt; int M, N, K; };

struct StaticOrder {
    int nM, nN, nwg, G, c;
    __device__ void init(int M, int N, int G_, int c_) { nM = M / BM; nN = N / BM; nwg = nM * nN; G = G_; c = c_; }
    __device__ bool next(int i, Unit& u) const {
        const long L = (long)i * G + c; if (L >= nwg) return false;
        int wgid = (int)L; { const int q = nwg / NXCD, r = nwg % NXCD, xcd = wgid % NXCD, off = wgid / NXCD; wgid = (xcd < r ? xcd * (q + 1) : r * (q + 1) + (xcd - r) * q) + off; }
        const int nig = WGM * nN, gid = wgid / nig, fm = gid * WGM, gsz = (nM - fm) < WGM ? (nM - fm) : WGM;
        u.pm = fm + ((wgid % nig) % gsz); u.pn = (wgid % nig) / gsz; return true;
    }
};

template <class Epi>
__device__ __forceinline__ void gemm_phase(LAS unsigned char* lds, const Gemm g, const StaticOrder& S, const Epi& E) {
    const int tid = threadIdx.x, wid = __builtin_amdgcn_readfirstlane(tid >> 6), lane = tid & 63, wr = wid >> 2, wc = wid & 3, fr = lane & 15, fq = lane >> 4;
    const int K = g.K, nt = K / BK;
    unsigned voffA[2], voffB[2];
#pragma unroll
    for (int i = 0; i < 2; ++i) { int R, C; stage_rc(tid * 16 + i * 8192, R, C); const int Rb = (R & ~31) + perm32(R & 31);
        voffA[i] = (unsigned)(R * K + C) * 2u; voffB[i] = (unsigned)(Rb * K + C) * 2u; }
    const size_t kstep = (size_t)(BK * 2);
    const size_t hstep = (size_t)HALF * K * 2;
    const size_t tstep = 2 * hstep;
    const unsigned ldsw = (unsigned)wid * 1024u;
    const int aoff = lds_byte(wr * 64 + fr, fq * 8), boff = lds_byte(wc * 32 + fr, fq * 8);
#define PG8_SA(b, h) (((b) * 2 + (h)) * HTB)
#define PG8_SB(b, h) ((4 + (b) * 2 + (h)) * HTB)
#define PG8_STAGE(bufoff, gbase, voff) do { _Pragma("unroll") for (int _i = 0; _i < 2; ++_i) \
        __builtin_amdgcn_global_load_lds((const unsigned*)((const char*)(gbase) + (voff)[_i]), (LAS unsigned*)(lds + (bufoff) + ldsw + _i * 8192), 16, 0, 0); } while (0)
#define PG8_LDA(dst, b, h) do { _Pragma("unroll") for (int m = 0; m < 4; ++m) _Pragma("unroll") for (int k = 0; k < 2; ++k) dst[m][k] = *(const LAS bf16x8*)(lds + PG8_SA(b, h) + aoff + m * 2048 + k * 1024); } while (0)
#define PG8_LDB(dst, b, h) do { _Pragma("unroll") for (int n = 0; n < 2; ++n) _Pragma("unroll") for (int k = 0; k < 2; ++k) dst[n][k] = *(const LAS bf16x8*)(lds + PG8_SB(b, h) + boff + n * 2048 + k * 1024); } while (0)
#define PG8_MMA(ai, bj, At, Bt) do { __builtin_amdgcn_s_setprio(1); _Pragma("unroll") for (int m = 0; m < 4; ++m) _Pragma("unroll") for (int n = 0; n < 2; ++n) _Pragma("unroll") for (int k = 0; k < 2; ++k) \
        acc[ai][bj][m][n] = __builtin_amdgcn_mfma_f32_16x16x32_bf16(Bt[n][k], At[m][k], acc[ai][bj][m][n], 0, 0, 0); __builtin_amdgcn_s_setprio(0); } while (0)
#define PG8_WAIT_V(n) asm volatile("s_waitcnt vmcnt(" #n ")" ::: "memory")
#define PG8_WAIT_L(n) asm volatile("s_waitcnt lgkmcnt(" #n ")" ::: "memory")
#define PG8_BAR __builtin_amdgcn_s_barrier()
#define PG8_SCHED __builtin_amdgcn_sched_barrier(0)
    Unit cur, nxt; int ui = 0;
    if (!S.next(0, cur)) return;
    f32x4 acc[2][2][4][2];
#pragma unroll
    for (int a = 0; a < 2; ++a)
#pragma unroll
        for (int b = 0; b < 2; ++b)
#pragma unroll
            for (int m = 0; m < 4; ++m)
#pragma unroll
                for (int n = 0; n < 2; ++n) acc[a][b][m][n] = (f32x4){0.f, 0.f, 0.f, 0.f};
    bf16x8 At[4][2], B0[2][2], B1[2][2];
    const char* cA = (const char*)g.A + (size_t)cur.pm * tstep; const char* cB = (const char*)g.Bt + (size_t)cur.pn * tstep;
#define PG8_STATS(pm_) do { if constexpr (Epi::STAB) { if (wr == 1) { const char* _sb = (const char*)E.st + (size_t)(pm_) * 16384 + (size_t)lane * 16; \
        _Pragma("unroll") for (int _i = 0; _i < 4; ++_i) __builtin_amdgcn_global_load_lds((const unsigned*)(_sb + ((wid - 4) + 4 * _i) * 1024), (LAS unsigned*)(lds + STAB_OFF + ((wid - 4) + 4 * _i) * 1024), 16, 0, 0); } } } while (0)
    PG8_STATS(cur.pm);
    PG8_STAGE(PG8_SB(0, 0), cB, voffB); PG8_STAGE(PG8_SB(0, 1), cB + hstep, voffB); PG8_STAGE(PG8_SA(0, 0), cA, voffA); PG8_STAGE(PG8_SA(0, 1), cA + hstep, voffA);
    if (wr == 1) PG8_BAR;
    PG8_WAIT_V(2); PG8_BAR;
    PG8_STAGE(PG8_SB(1, 0), cB + kstep, voffB); PG8_STAGE(PG8_SA(1, 0), cA + kstep, voffA); PG8_STAGE(PG8_SB(1, 1), cB + hstep + kstep, voffB);
    PG8_WAIT_V(6); PG8_BAR;
    for (;;) {
        const bool has_next = S.next(ui + 1, nxt);
        const char* nA = has_next ? (const char*)g.A + (size_t)nxt.pm * tstep : cA; const char* nB = has_next ? (const char*)g.Bt + (size_t)nxt.pn * tstep : cB;
        for (int t = 0; t < nt; t += 2) {
            const bool last = (t == nt - 2);
            const char* a1 = cA + (size_t)(t + 1) * kstep;
            const char* a2 = last ? nA : cA + (size_t)(t + 2) * kstep; const char* b2 = last ? nB : cB + (size_t)(t + 2) * kstep;
            const char* a3 = a2 + kstep; const char* b3 = b2 + kstep;
            if constexpr (Epi::MIDK > 0) { if (t == Epi::MIDK) E.mid(acc, cur, wr, wc, fr, fq); }
            PG8_LDB(B0, 0, 0); PG8_LDB(B1, 0, 1); PG8_SCHED; PG8_LDA(At, 0, 0); PG8_STAGE(PG8_SA(1, 1), a1 + hstep, voffA);
            PG8_WAIT_V(8); PG8_WAIT_L(0); PG8_BAR; PG8_MMA(0, 0, At, B0); PG8_MMA(0, 1, At, B1); PG8_BAR; PG8_SCHED;
            PG8_LDA(At, 0, 1); PG8_STAGE(PG8_SB(0, 0), b2, voffB); PG8_STAGE(PG8_SB(0, 1), b2 + hstep, voffB); PG8_STAGE(PG8_SA(0, 0), a2, voffA);
            PG8_WAIT_V(8); PG8_WAIT_L(0); PG8_BAR; PG8_MMA(1, 0, At, B0); PG8_MMA(1, 1, At, B1); PG8_BAR; PG8_SCHED;
            PG8_LDB(B0, 1, 0); PG8_LDB(B1, 1, 1); PG8_SCHED; PG8_LDA(At, 1, 0); PG8_STAGE(PG8_SA(0, 1), a2 + hstep, voffA);
            PG8_WAIT_V(8); PG8_WAIT_L(0); PG8_BAR; PG8_MMA(0, 0, At, B0); PG8_MMA(0, 1, At, B1); PG8_BAR; PG8_SCHED;
            PG8_LDA(At, 1, 1); PG8_STAGE(PG8_SB(1, 0), b3, voffB); PG8_STAGE(PG8_SB(1, 1), b3 + hstep, voffB); PG8_STAGE(PG8_SA(1, 0), a3, voffA);
            PG8_WAIT_V(8); PG8_WAIT_L(0); PG8_BAR; PG8_MMA(1, 0, At, B0); PG8_MMA(1, 1, At, B1); PG8_BAR; PG8_SCHED;
        }
        if (wr == 0) PG8_BAR;
        E(acc, cur, wr, wc, fr, fq);
        if (!has_next) break;
#pragma unroll
        for (int a = 0; a < 2; ++a)
#pragma unroll
            for (int b = 0; b < 2; ++b)
#pragma unroll
                for (int m = 0; m < 4; ++m)
#pragma unroll
                    for (int n = 0; n < 2; ++n) acc[a][b][m][n] = (f32x4){0.f, 0.f, 0.f, 0.f};
        cur = nxt; cA = nA; cB = nB; ++ui;
        if (wr == 1) PG8_BAR;
        PG8_STATS(cur.pm);
    }
    PG8_WAIT_V(0);
    PG8_BAR;
#undef PG8_STATS
#undef PG8_SA
#undef PG8_SB
#undef PG8_STAGE
#undef PG8_LDA
#undef PG8_LDB
#undef PG8_MMA
#undef PG8_WAIT_V
#undef PG8_WAIT_L
#undef PG8_BAR
#undef PG8_SCHED
}
}
using pg8::Unit;
typedef f32x4 Acc[2][2][4][2];
#define FENCE() asm volatile("" ::: "memory")

struct EpiSwiGLU {
    static constexpr int MIDK = 0; static constexpr bool STAB = true;
    bf16_t* O; const float* st;
    __device__ __forceinline__ void mid(Acc&, const Unit&, int, int, int, int) const {}
    __device__ __forceinline__ void operator()(const Acc& acc, const Unit& u, int wr, int wc, int fr, int fq) const {
        const int col = u.pn * 128 + wc * 32 + fq * 8;
        float rsv[2][4]; rstd8_lds(wr * 64 + fr, fq, 1.0f / 1024.0f, rsv);
#pragma unroll
        for (int ai = 0; ai < 2; ++ai)
#pragma unroll
            for (int m = 0; m < 4; ++m) {
                const int r = u.pm * 256 + ai * 128 + wr * 64 + m * 16 + fr;
                const float rs = rsv[ai][m], nrs = -LOG2E * rs, rs2 = rs * rs;
                u32x4 w;
#pragma unroll
                for (int n = 0; n < 2; ++n) {
                    const f32x4 ga = acc[ai][0][m][n], ua = acc[ai][1][m][n];
                    const f32x4 sg = sig_from_negl2(ga * nrs);
                    const u32x2 pk = pack4((ga * ua) * rs2 * sg);
                    if (n == 0) { w.x = pk.x; w.y = pk.y; } else { w.z = pk.x; w.w = pk.y; }
                }
                *(u32x4*)(O + (size_t)r * DFF + col) = w;
            }
    }
};

template <bool RES_BF16, bool OUT_F32>
struct EpiRes {
    static constexpr int MIDK = 0; static constexpr bool STAB = false;
    const float* baseA; const float* baseB; const bf16_t* resb; float* out; bf16_t* xb; float* st; float scale;
    __device__ __forceinline__ void mid(Acc&, const Unit&, int, int, int, int) const {}
    __device__ __forceinline__ void operator()(const Acc& acc, const Unit& u, int wr, int wc, int fr, int fq) const {
        const int col = u.pn * 256 + wc * 32 + fq * 8;
        const int rb = u.pm * 256 + wr * 64 + fr;
        const float* bbase = RES_BF16 ? nullptr : (rb < MP ? baseA : baseB) + (size_t)rb * DM + col;
        const bf16_t* rbase = RES_BF16 ? resb + (size_t)rb * DM + col : nullptr;
        f32x4 pre[2][2][2]; u32x4 preb[2][2];
#pragma unroll
        for (int bj = 0; bj < 2; ++bj) {
            if constexpr (RES_BF16) preb[0][bj] = *(const u32x4*)(rbase + bj * 128);
            else { pre[0][bj][0] = *(const f32x4*)(bbase + bj * 128); pre[0][bj][1] = *(const f32x4*)(bbase + bj * 128 + 4); }
        }
#pragma unroll
        for (int i = 0; i < 8; ++i) {
            const int ai = i >> 2, m = i & 3, cb = i & 1, nb = cb ^ 1;
            if (i < 7) { const int ai2 = (i + 1) >> 2, m2 = (i + 1) & 3; const size_t ro = (size_t)(ai2 * 128 + m2 * 16) * DM;
#pragma unroll
                for (int bj = 0; bj < 2; ++bj) {
                    if constexpr (RES_BF16) preb[nb][bj] = *(const u32x4*)(rbase + ro + bj * 128);
                    else { pre[nb][bj][0] = *(const f32x4*)(bbase + ro + bj * 128); pre[nb][bj][1] = *(const f32x4*)(bbase + ro + bj * 128 + 4); }
                }
            }
            FENCE();
            const int r = rb + ai * 128 + m * 16;
            float q = 0.f;
#pragma unroll
            for (int bj = 0; bj < 2; ++bj) {
                f32x4 b0, b1;
                if constexpr (RES_BF16) { const u32x4 w = preb[cb][bj]; b0 = (f32x4){bflo(w.x), bfhi(w.x), bflo(w.y), bfhi(w.y)}; b1 = (f32x4){bflo(w.z), bfhi(w.z), bflo(w.w), bfhi(w.w)}; }
                else { b0 = pre[cb][bj][0]; b1 = pre[cb][bj][1]; }
                const f32x4 v0 = b0 + acc[ai][bj][m][0] * scale, v1 = b1 + acc[ai][bj][m][1] * scale;
                if constexpr (OUT_F32) { float* op = out + (size_t)r * DM + col + bj * 128; *(f32x4*)op = v0; *(f32x4*)(op + 4) = v1; }
                q += (v0[0] * v0[0] + v0[1] * v0[1]) + (v0[2] * v0[2] + v0[3] * v0[3]) + (v1[0] * v1[0] + v1[1] * v1[1]) + (v1[2] * v1[2] + v1[3] * v1[3]);
                if (xb) { u32x4 w; w.x = cvtpk(v0[0], v0[1]); w.y = cvtpk(v0[2], v0[3]); w.z = cvtpk(v1[0], v1[1]); w.w = cvtpk(v1[2], v1[3]);
                    *(u32x4*)(xb + (size_t)r * DM + col + bj * 128) = w; }
            }
            q += __shfl_xor(q, 16); q += __shfl_xor(q, 32);
            if (fq == 0) st[(size_t)r * 16 + u.pn * 4 + wc] = q;
            FENCE();
        }
    }
};

struct EpiMixA {
    static constexpr int MIDK = 0; static constexpr bool STAB = true;
    bf16_t* UQ; bf16_t* VA; bf16_t* KB; bf16_t* VB; const float* st; float* stv; const float* qn; const float* kn;
    __device__ __forceinline__ void mid(Acc&, const Unit&, int, int, int, int) const {}
    __device__ __forceinline__ void operator()(const Acc& acc, const Unit& u, int wr, int wc, int fr, int fq) const {
        const int t = u.pn;
        if (t < 4 || t >= 8) {
            bf16_t* base; int pitch, c0; const bool act = t < 4;
            if (t < 2) { base = UQ; pitch = DM; c0 = 256 * t; } else if (t < 4) { base = VA; pitch = 512; c0 = 256 * (t - 2); } else { base = VB; pitch = 512; c0 = 256 * (t - 8); }
            const int col = c0 + wc * 32 + fq * 8;
            float rsv[2][4]; rstd8_lds(wr * 64 + fr, fq, 1.0f / 1024.0f, rsv);
#pragma unroll
            for (int ai = 0; ai < 2; ++ai)
#pragma unroll
                for (int m = 0; m < 4; ++m) {
                    const int r = u.pm * 256 + ai * 128 + wr * 64 + m * 16 + fr;
                    const float rs = rsv[ai][m];
                    float q = 0.f;
#pragma unroll
                    for (int bj = 0; bj < 2; ++bj) {
                        u32x4 w;
#pragma unroll
                        for (int n = 0; n < 2; ++n) {
                            f32x4 v = acc[ai][bj][m][n] * rs;
                            if (act) {
                                const f32x4 x2 = v * v;
                                const f32x4 t = v * (x2 * (-2.0f * 0.7978845608028654f * LOG2E * 0.044715f) + (-2.0f * 0.7978845608028654f * LOG2E));
                                v = v * sig_from_negl2(t);
                            }
                            if (t == 2 || t == 3) { const f32x4 v2 = v * v; q += (v2[0] + v2[1]) + (v2[2] + v2[3]); }
                            const u32x2 pk = pack4(v);
                            if (n == 0) { w.x = pk.x; w.y = pk.y; } else { w.z = pk.x; w.w = pk.y; }
                        }
                        *(u32x4*)(base + (size_t)r * pitch + col + bj * 128) = w;
                    }
                    if (t == 2 || t == 3) { q += __shfl_xor(q, 16); q += __shfl_xor(q, 32); if (fq == 0) stv[(size_t)r * 16 + (t - 2) * 4 + wc] = q; }
                }
        } else {
            const bool isq = t < 6;
            const float* gn = isq ? qn : kn; const float sc = isq ? QSCALE : 1.0f;
            f32x4 gv[2][2];
#pragma unroll
            for (int bj = 0; bj < 2; ++bj)
#pragma unroll
                for (int n = 0; n < 2; ++n) gv[bj][n] = *(const f32x4*)(gn + 32 * bj + 8 * fq + 4 * n) * sc;
            bf16_t* base = isq ? (UQ + 512 + 256 * (t - 4)) : (KB + 256 * (t - 6));
            const int pitch = isq ? DM : 512;
            const int col = wc * 64 + fq * 8;
            float rsv[2][4]; rstd8_lds(wr * 64 + fr, fq, 1.0f / 1024.0f, rsv);
#pragma unroll
            for (int ai = 0; ai < 2; ++ai)
#pragma unroll
                for (int m = 0; m < 4; ++m) {
                    const int r = u.pm * 256 + ai * 128 + wr * 64 + m * 16 + fr;
                    const float rs = rsv[ai][m];
                    f32x4 v[2][2]; float q = 0.f;
#pragma unroll
                    for (int bj = 0; bj < 2; ++bj)
#pragma unroll
                        for (int n = 0; n < 2; ++n) { v[bj][n] = acc[ai][bj][m][n] * rs; const f32x4 x = v[bj][n]; q += (x[0] * x[0] + x[1] * x[1]) + (x[2] * x[2] + x[3] * x[3]); }
                    q += __shfl_xor(q, 16); q += __shfl_xor(q, 32);
                    const float rq = __builtin_amdgcn_rsqf(q * (1.0f / 64.0f) + EPS);
#pragma unroll
                    for (int bj = 0; bj < 2; ++bj) {
                        const f32x4 a = v[bj][0] * gv[bj][0] * rq, b = v[bj][1] * gv[bj][1] * rq;
                        u32x4 w; w.x = cvtpk(a[0], a[1]); w.y = cvtpk(a[2], a[3]); w.z = cvtpk(b[0], b[1]); w.w = cvtpk(b[2], b[3]);
                        *(u32x4*)(base + (size_t)r * pitch + col + bj * 32) = w;
                    }
                }
        }
    }
};

struct EpiGate {
    static constexpr int MIDK = 0; static constexpr bool STAB = true;
    bf16_t* GA; bf16_t* GB; const float* st; const float* gbias;
    __device__ __forceinline__ void mid(Acc&, const Unit&, int, int, int, int) const {}
    __device__ __forceinline__ void operator()(const Acc& acc, const Unit& u, int wr, int wc, int fr, int fq) const {
        bf16_t* base = u.pn < 4 ? GA : GB; const int col = (u.pn & 3) * 256 + wc * 32 + fq * 8;
        const float* bp = gbias + u.pn * 256 + wc * 32 + fq * 8;
        f32x4 bv[2][2];
#pragma unroll
        for (int bj = 0; bj < 2; ++bj)
#pragma unroll
            for (int n = 0; n < 2; ++n) bv[bj][n] = *(const f32x4*)(bp + bj * 128 + 4 * n) * (-LOG2E);
        float rsv[2][4]; rstd8_lds(wr * 64 + fr, fq, 1.0f / 1024.0f, rsv);
#pragma unroll
        for (int ai = 0; ai < 2; ++ai)
#pragma unroll
            for (int m = 0; m < 4; ++m) {
                const int r = u.pm * 256 + ai * 128 + wr * 64 + m * 16 + fr;
                const float nrs = -LOG2E * rsv[ai][m];
#pragma unroll
                for (int bj = 0; bj < 2; ++bj) {
                    const u32x2 p0 = pack4(sig_from_negl2(acc[ai][bj][m][0] * nrs + bv[bj][0])), p1 = pack4(sig_from_negl2(acc[ai][bj][m][1] * nrs + bv[bj][1]));
                    u32x4 w; w.x = p0.x; w.y = p0.y; w.z = p1.x; w.w = p1.y;
                    *(u32x4*)(base + (size_t)r * DM + col + bj * 128) = w;
                }
            }
    }
};

struct EpiMerge {
    static constexpr int MIDK = 8; static constexpr bool STAB = false;
    const bf16_t* GA; const bf16_t* GB; bf16_t* MG;
    __device__ __forceinline__ void mid(Acc& acc, const Unit& u, int wr, int wc, int fr, int fq) const {
        int col = u.pn * 256 + wc * 32 + fq * 8, rb = u.pm * 256 + wr * 64 + fr;
        asm volatile("" : "+v"(col), "+v"(rb));
#pragma unroll
        for (int ai = 0; ai < 2; ++ai)
#pragma unroll
            for (int m = 0; m < 4; ++m) {
                const int r = rb + ai * 128 + m * 16;
#pragma unroll
                for (int bj = 0; bj < 2; ++bj) {
                    const u32x4 a = *(const u32x4*)(GA + (size_t)r * DM + col + bj * 128), b = *(const u32x4*)(GB + (size_t)r * DM + col + bj * 128);
                    f32x4 r0, r1;
                    r0[0] = bflo(a.x) * fast_rcp(bflo(b.x)); r0[1] = bfhi(a.x) * fast_rcp(bfhi(b.x)); r0[2] = bflo(a.y) * fast_rcp(bflo(b.y)); r0[3] = bfhi(a.y) * fast_rcp(bfhi(b.y));
                    r1[0] = bflo(a.z) * fast_rcp(bflo(b.z)); r1[1] = bfhi(a.z) * fast_rcp(bfhi(b.z)); r1[2] = bflo(a.w) * fast_rcp(bflo(b.w)); r1[3] = bfhi(a.w) * fast_rcp(bfhi(b.w));
                    acc[ai][bj][m][0] *= r0; acc[ai][bj][m][1] *= r1;
                }
                if (m & 1) FENCE();
            }
    }
    __device__ __forceinline__ void operator()(const Acc& acc, const Unit& u, int wr, int wc, int fr, int fq) const {
        const int col = u.pn * 256 + wc * 32 + fq * 8;
        u32x4 gb[2][4][2];
#pragma unroll
        for (int ai = 0; ai < 2; ++ai)
#pragma unroll
            for (int m = 0; m < 4; ++m)
#pragma unroll
                for (int bj = 0; bj < 2; ++bj) gb[ai][m][bj] = *(const u32x4*)(GB + (size_t)(u.pm * 256 + ai * 128 + wr * 64 + m * 16 + fr) * DM + col + bj * 128);
        FENCE();
#pragma unroll
        for (int ai = 0; ai < 2; ++ai)
#pragma unroll
            for (int m = 0; m < 4; ++m) {
                const int r = u.pm * 256 + ai * 128 + wr * 64 + m * 16 + fr;
#pragma unroll
                for (int bj = 0; bj < 2; ++bj) {
                    const u32x4 b = gb[ai][m][bj];
                    const f32x4 v0 = acc[ai][bj][m][0], v1 = acc[ai][bj][m][1];
                    u32x4 w; w.x = cvtpk(v0[0] * bflo(b.x), v0[1] * bfhi(b.x)); w.y = cvtpk(v0[2] * bflo(b.y), v0[3] * bfhi(b.y));
                    w.z = cvtpk(v1[0] * bflo(b.z), v1[1] * bfhi(b.z)); w.w = cvtpk(v1[2] * bflo(b.w), v1[3] * bfhi(b.w));
                    *(u32x4*)(MG + (size_t)r * DM + col + bj * 128) = w;
                }
                if (m & 1) FENCE();
            }
    }
};

struct Params { const float* in[26]; float* out; unsigned char* ws; int ph_lo, ph_hi; };

__device__ __forceinline__ void transpose_item(const float* W, int ldw, int k0, int srccol0, const float* gain, bf16_t* dst, int dpitch, int drow0, int dk0, LAS float* scr, int lane) {
    float tv[32];
#pragma unroll
    for (int i = 0; i < 32; ++i) { const int kk = 2 * i + (lane >> 5); tv[i] = W[(size_t)(k0 + kk) * ldw + srccol0 + (lane & 31)]; }
    if (gain) {
#pragma unroll
        for (int i = 0; i < 32; ++i) tv[i] *= gain[k0 + 2 * i + (lane >> 5)];
    }
#pragma unroll
    for (int i = 0; i < 32; ++i) { const int kk = 2 * i + (lane >> 5); scr[kk * 33 + (lane & 31)] = tv[i]; }
    asm volatile("s_waitcnt lgkmcnt(0)" ::: "memory");
    const int c = lane & 7;
#pragma unroll
    for (int j = 0; j < 4; ++j) { const int n = (lane >> 3) + 8 * j; const LAS float* s = scr + (8 * c) * 33 + n;
        u32x4 o; o.x = cvtpk(s[0 * 33], s[1 * 33]); o.y = cvtpk(s[2 * 33], s[3 * 33]); o.z = cvtpk(s[4 * 33], s[5 * 33]); o.w = cvtpk(s[6 * 33], s[7 * 33]);
        *(u32x4*)(dst + (size_t)(drow0 + n) * dpitch + dk0 + k0 + 8 * c) = o; }
    asm volatile("s_waitcnt lgkmcnt(0)" ::: "memory");
}
__device__ __forceinline__ int map_ffn_in(int n) { const int pn = n >> 8, p = n & 255; return p < 128 ? 128 * pn + p : DFF + 128 * pn + (p - 128); }
__device__ __forceinline__ int map_win(int n) { if (n < 1024 || n >= 2048) return n; const int pn = n >> 8, p = n & 255, bj = p >> 7, wc = (p & 127) >> 5, j = p & 31; return 256 * pn + 64 * wc + 32 * bj + j; }

__device__ __forceinline__ void prologue(const Params& P, LAS unsigned char* lds, int gw, int NGW, int wave, int lane) {
    unsigned char* ws = P.ws;
    LAS float* scr = (LAS float*)(lds + wave * 16384);
    constexpr int I_IN = 16 * 176, I_OUT = 44 * 32, I_WIN = 16 * 144, I_P = 8 * 32, I_O = 16 * 32;
    constexpr int NITEMS = 2 * I_IN + 2 * I_OUT + I_WIN + 2 * I_P + I_O;
    for (int it = gw; it < NITEMS; it += NGW) {
        int r = it;
        if (r < 2 * I_IN) { const int w = r / I_IN; r -= w * I_IN; const int kb = r / 176, nb = r % 176;
            transpose_item(P.in[w ? 23 : 4], 2 * DFF, 64 * kb, map_ffn_in(32 * nb), P.in[w ? 22 : 3], (bf16_t*)(ws + (w ? WS_W2IN : WS_W1IN)), 1024, 32 * nb, 0, scr, lane); continue; }
        r -= 2 * I_IN;
        if (r < 2 * I_OUT) { const int w = r / I_OUT; r -= w * I_OUT; const int kb = r / 32, nb = r % 32;
            transpose_item(P.in[w ? 24 : 5], DM, 64 * kb, 32 * nb, nullptr, (bf16_t*)(ws + (w ? WS_W2OUT : WS_W1OUT)), DFF, 32 * nb, 0, scr, lane); continue; }
        r -= 2 * I_OUT;
        if (r < I_WIN) { const int kb = r / 144, nb = r % 144;
            transpose_item(P.in[7], NIN, 64 * kb, map_win(32 * nb), P.in[6], (bf16_t*)(ws + WS_WIN), 1024, 32 * nb, 0, scr, lane); continue; }
        r -= I_WIN;
        if (r < 2 * I_P) { const int w = r / I_P; r -= w * I_P; const int kb = r / 32, nb = r % 32;
            transpose_item(P.in[w ? 20 : 19], DM, 64 * kb, 32 * nb, nullptr, (bf16_t*)(ws + WS_WP), 1024, 32 * nb, w ? 512 : 0, scr, lane); continue; }
        r -= 2 * I_P;
        { const int kb = r / 32, nb = r % 32; transpose_item(P.in[21], DM, 64 * kb, 32 * nb, nullptr, (bf16_t*)(ws + WS_WO), 1024, 32 * nb, 0, scr, lane); }
    }
    { bf16_t* d = (bf16_t*)(ws + WS_SGUW); const float* s = P.in[10];
      for (int i = gw * 64 + lane; i < 8 * 128 * 128; i += NGW * 64) { const int lo = i & 31, hi = i & ~31, f = lo >> 3, e = lo & 7; const int src = hi + (e < 4 ? 4 * f + e : 16 + 4 * f + e - 4);
          const unsigned w = cvtpk(s[src], 0.f); d[i] = (bf16_t)(w & 0xffffu); } }
    { bf16_t* xb = (bf16_t*)(ws + WS_XB); float* st = (float*)(ws + WS_STA);
      for (int m = gw; m < MT; m += 4 * NGW) {
          const float* xr[4]; int mr[4]; bool ok[4];
#pragma unroll
          for (int k = 0; k < 4; ++k) { const int mk = m + k * NGW; ok[k] = mk < MT; mr[k] = ok[k] ? mk : m; xr[k] = (mr[k] < MP ? P.in[0] + (size_t)mr[k] * DM : P.in[1] + (size_t)(mr[k] - MP) * DM); }
          f32x4 v[4][4];
#pragma unroll
          for (int k = 0; k < 4; ++k)
#pragma unroll
              for (int j = 0; j < 4; ++j) v[k][j] = ((const f32x4*)xr[k] + lane)[64 * j];
#pragma unroll
          for (int k = 0; k < 4; ++k) {
              float sq = 0.f;
#pragma unroll
              for (int j = 0; j < 4; ++j) sq += (v[k][j][0] * v[k][j][0] + v[k][j][1] * v[k][j][1]) + (v[k][j][2] * v[k][j][2] + v[k][j][3] * v[k][j][3]);
              sq = wave_sum(sq);
              if (ok[k]) {
                  u32x2* o = (u32x2*)(xb + (size_t)mr[k] * DM) + lane;
#pragma unroll
                  for (int j = 0; j < 4; ++j) { u32x2 w; w.x = cvtpk(v[k][j][0], v[k][j][1]); w.y = cvtpk(v[k][j][2], v[k][j][3]); o[64 * j] = w; }
                  if (lane < 4) { const f32x4 z = {lane == 0 ? sq : 0.f, 0.f, 0.f, 0.f}; *(f32x4*)(st + (size_t)mr[k] * 16 + 4 * lane) = z; }
              }
          }
      } }
}

constexpr int AT_TILE = 64 * 256;
constexpr int AT_K0 = 0, AT_V0 = 3 * AT_TILE, AT_TAB = 7 * AT_TILE;
static_assert(AT_TAB + 260 * 4 <= 131072, "attention LDS");

__device__ __forceinline__ int t5_bucket(int rel) {
    int b = rel > 0 ? 16 : 0; const int n = rel < 0 ? -rel : rel;
    if (n < 8) return b + n;
    const float nf = (float)n;
    int large = 8 + (int)(logf(nf / 8.0f) / 2.772588722239781f * 8.0f);
    large = large < 15 ? large : 15;
    return b + large;
}
#define AT_TR(dst, addr, OFF) asm volatile("ds_read_b64_tr_b16 %0, %1 offset:%2" : "=&v"(dst) : "v"(addr), "i"(OFF))

__device__ __forceinline__ void attn_pv(unsigned vaddr, const int (&vo)[8], const bf16x8 (&pf)[2][2], f32x4 (&o)[2][8], f32x4 (&ol)[2]) {
    s16x4 r[3][4];
#define AT_TR4(slot, d) do { const unsigned _a = vaddr + (unsigned)vo[d]; AT_TR(r[slot][0], _a, 0); AT_TR(r[slot][1], _a, 16 * 256); AT_TR(r[slot][2], _a, 32 * 256); AT_TR(r[slot][3], _a, 48 * 256); } while (0)
    AT_TR4(0, 0); AT_TR4(1, 1);
    { const bf16x8 ones = (bf16x8){0x3f80, 0x3f80, 0x3f80, 0x3f80, 0x3f80, 0x3f80, 0x3f80, 0x3f80};
#pragma unroll
      for (int c = 0; c < 2; ++c)
#pragma unroll
          for (int si = 0; si < 2; ++si) ol[c] = __builtin_amdgcn_mfma_f32_16x16x32_bf16(ones, pf[c][si], ol[c], 0, 0, 0); }
#pragma unroll
    for (int dt = 0; dt < 8; ++dt) {
        const int cb = dt % 3;
        if (dt < 6) { AT_TR4((dt + 2) % 3, dt + 2); asm volatile("s_waitcnt lgkmcnt(8)" : "+v"(r[cb][0]), "+v"(r[cb][1]), "+v"(r[cb][2]), "+v"(r[cb][3])); }
        else if (dt == 6) asm volatile("s_waitcnt lgkmcnt(4)" : "+v"(r[cb][0]), "+v"(r[cb][1]), "+v"(r[cb][2]), "+v"(r[cb][3]));
        else asm volatile("s_waitcnt lgkmcnt(0)" : "+v"(r[cb][0]), "+v"(r[cb][1]), "+v"(r[cb][2]), "+v"(r[cb][3]));
#pragma unroll
        for (int si = 0; si < 2; ++si) {
            const s16x4 lo = r[cb][2 * si], hi = r[cb][2 * si + 1];
            const bf16x8 vf = (bf16x8){lo[0], lo[1], lo[2], lo[3], hi[0], hi[1], hi[2], hi[3]};
            o[0][dt] = __builtin_amdgcn_mfma_f32_16x16x32_bf16(vf, pf[0][si], o[0][dt], 0, 0, 0);
            o[1][dt] = __builtin_amdgcn_mfma_f32_16x16x32_bf16(vf, pf[1][si], o[1][dt], 0, 0, 0);
        }
    }
#undef AT_TR4
}

template <bool QK, bool PV>
__device__ __forceinline__ void attn_step(const LAS unsigned char* kbuf, unsigned vaddr, const int (&kfo)[2][2], const int (&vo)[8],
                                          const bf16x8 (&qf)[2][2], f32x4 (&s)[2][4], bf16x8 (&pf)[2][2], f32x4 (&o)[2][8], f32x4 (&ol)[2], const f32x4 (&tbv)[4]) {
    bf16x8 pn[2][2];
    s16x4 r[3][4];
#define AT_TR4(slot, d) do { const unsigned _a = vaddr + (unsigned)vo[d]; AT_TR(r[slot][0], _a, 0); AT_TR(r[slot][1], _a, 16 * 256); AT_TR(r[slot][2], _a, 32 * 256); AT_TR(r[slot][3], _a, 48 * 256); } while (0)
    if constexpr (PV) { AT_TR4(0, 0); AT_TR4(1, 1);
        const bf16x8 ones = (bf16x8){0x3f80, 0x3f80, 0x3f80, 0x3f80, 0x3f80, 0x3f80, 0x3f80, 0x3f80};
#pragma unroll
        for (int c = 0; c < 2; ++c)
#pragma unroll
            for (int si = 0; si < 2; ++si) ol[c] = __builtin_amdgcn_mfma_f32_16x16x32_bf16(ones, pf[c][si], ol[c], 0, 0, 0); }
#pragma unroll
    for (int dt = 0; dt < 8; ++dt) {
        if constexpr (PV) {
            const int cb = dt % 3;
            if (dt < 6) { AT_TR4((dt + 2) % 3, dt + 2); asm volatile("s_waitcnt lgkmcnt(8)" : "+v"(r[cb][0]), "+v"(r[cb][1]), "+v"(r[cb][2]), "+v"(r[cb][3])); }
            else if (dt == 6) asm volatile("s_waitcnt lgkmcnt(4)" : "+v"(r[cb][0]), "+v"(r[cb][1]), "+v"(r[cb][2]), "+v"(r[cb][3]));
            else asm volatile("s_waitcnt lgkmcnt(0)" : "+v"(r[cb][0]), "+v"(r[cb][1]), "+v"(r[cb][2]), "+v"(r[cb][3]));
#pragma unroll
            for (int si = 0; si < 2; ++si) {
                const s16x4 lo = r[cb][2 * si], hi = r[cb][2 * si + 1];
                const bf16x8 vf = (bf16x8){lo[0], lo[1], lo[2], lo[3], hi[0], hi[1], hi[2], hi[3]};
                o[0][dt] = __builtin_amdgcn_mfma_f32_16x16x32_bf16(vf, pf[0][si], o[0][dt], 0, 0, 0);
                o[1][dt] = __builtin_amdgcn_mfma_f32_16x16x32_bf16(vf, pf[1][si], o[1][dt], 0, 0, 0);
            }
        }
        {
            const int c = dt >> 2, kt = dt & 3;
#pragma unroll
            for (int j = 0; j < 4; ++j) s[c][kt][j] = fast_exp2(s[c][kt][j]);
            if (kt & 1) { const int si = kt >> 1;
                u32x4 wv; wv.x = cvtpk(s[c][2 * si][0], s[c][2 * si][1]); wv.y = cvtpk(s[c][2 * si][2], s[c][2 * si][3]);
                wv.z = cvtpk(s[c][2 * si + 1][0], s[c][2 * si + 1][1]); wv.w = cvtpk(s[c][2 * si + 1][2], s[c][2 * si + 1][3]);
                pn[c][si] = __builtin_bit_cast(bf16x8, wv); }
        }
    }
#undef AT_TR4
#pragma unroll
    for (int c = 0; c < 2; ++c)
#pragma unroll
        for (int si = 0; si < 2; ++si) pf[c][si] = pn[c][si];
    if constexpr (QK) {
#pragma unroll
        for (int kt = 0; kt < 4; ++kt)
#pragma unroll
            for (int c = 0; c < 2; ++c) {
                f32x4 a = tbv[kt];
#pragma unroll
                for (int kk = 0; kk < 2; ++kk) { const bf16x8 kf = *(const LAS bf16x8*)(kbuf + kfo[c][kk] + kt * 4096); a = __builtin_amdgcn_mfma_f32_16x16x32_bf16(kf, qf[c][kk], a, 0, 0, 0); }
                s[c][kt] = a;
            }
    }
}

__device__ __forceinline__ void attn_unit(LAS unsigned char* lds, int seq, int h, int qb, bf16_t* UQ, const bf16_t* KB, const bf16_t* VB, const float* rel_bias, const float* subln, float lam, float bmax) {
    const int tid = threadIdx.x, lane = tid & 63, w = __builtin_amdgcn_readfirstlane(tid >> 6), r16 = lane & 15, fq = lane >> 4;
    int row0, S; if (seq < NSEQ_P) { row0 = seq * SEQ_P; S = SEQ_P; } else { row0 = MP + (seq - NSEQ_P) * SEQ_S; S = SEQ_S; }
    const int q0 = qb * 128, NT = S / 64, tmask = NT - 1, tstart = 2 * qb;
    const LAS unsigned char* tab = lds + AT_TAB;
    const unsigned lds0 = (unsigned)(size_t)lds;
    if (tid < 257) ((LAS float*)(lds + AT_TAB))[tid] = LOG2E * (rel_bias[t5_bucket(tid - 128) * 4 + h] - bmax);
    bf16x8 qf[2][2];
    { const bf16_t* qp = UQ + (size_t)(row0 + q0 + 16 * w + r16) * DM + 512 + 128 * h + 8 * fq;
#pragma unroll
      for (int c = 0; c < 2; ++c)
#pragma unroll
          for (int kk = 0; kk < 2; ++kk) qf[c][kk] = *(const bf16x8*)(qp + 64 * c + 32 * kk); }
    f32x4 o[2][8];
#pragma unroll
    for (int c = 0; c < 2; ++c)
#pragma unroll
        for (int d = 0; d < 8; ++d) o[c][d] = (f32x4){0.f, 0.f, 0.f, 0.f};
    f32x4 ol[2] = {(f32x4){0.f, 0.f, 0.f, 0.f}, (f32x4){0.f, 0.f, 0.f, 0.f}};
    unsigned kso[2], vso[2];
#pragma unroll
    for (int i = 0; i < 2; ++i) { const int row = 4 * (2 * w + i) + (lane >> 4), pos = lane & 15;
        kso[i] = (unsigned)(row * 512 + 8 * (pos ^ (row & 15))) * 2u; vso[i] = (unsigned)(row * 512 + 8 * (pos ^ (2 * (row & 7)))) * 2u; }
    const char* kg = (const char*)(KB + (size_t)row0 * 512 + 128 * h);
    const char* vg = (const char*)(VB + (size_t)row0 * 512 + 128 * h);
#define AT_STAGE(gbase, so, i, ldsoff) do { const int _ii = (i) < NT ? (i) : NT - 1; const size_t _go = (size_t)((tstart + _ii) & tmask) * (64 * 1024); _Pragma("unroll") for (int _i = 0; _i < 2; ++_i) \
        __builtin_amdgcn_global_load_lds((const unsigned*)((gbase) + _go + (so)[_i]), (LAS unsigned*)(lds + (ldsoff) + (2 * w + _i) * 1024), 16, 0, 0); } while (0)
#define AT_BAR(N) asm volatile("s_waitcnt vmcnt(" #N ") lgkmcnt(0)\n\ts_barrier" ::: "memory")
    AT_STAGE(kg, kso, 0, AT_K0); AT_STAGE(vg, vso, 0, AT_V0); AT_STAGE(kg, kso, 1, AT_K0 + AT_TILE); AT_STAGE(vg, vso, 1, AT_V0 + AT_TILE); AT_STAGE(kg, kso, 2, AT_K0 + 2 * AT_TILE);
    int kfo[2][2], vo[8];
#pragma unroll
    for (int c = 0; c < 2; ++c)
#pragma unroll
        for (int kk = 0; kk < 2; ++kk) kfo[c][kk] = r16 * 256 + (((8 * c + 4 * kk + fq) ^ r16) * 16);
    { const int rk = 4 * (fq & 1) + (r16 >> 2);
#pragma unroll
      for (int dt = 0; dt < 8; ++dt) vo[dt] = (4 * fq + (r16 >> 2)) * 256 + ((dt ^ rk) * 32) + (r16 & 3) * 8; }
    const int qrow = q0 + 16 * w;
    const int tixb = (4 * fq - (qrow + r16) + 128) * 4;
    f32x4 s[2][4]; bf16x8 pf[2][2];
#pragma unroll
    for (int c = 0; c < 2; ++c)
#pragma unroll
        for (int si = 0; si < 2; ++si) pf[c][si] = (bf16x8){0, 0, 0, 0, 0, 0, 0, 0};
    AT_BAR(0);
    const float tbL = *(const LAS float*)(tab), tbR = *(const LAS float*)(tab + 1024);
    f32x4 tbv[4];
#define AT_TB(jt) do { const int _k0 = (jt) * 64; const int _rmax = _k0 + 63 - qrow, _rmin = _k0 - (qrow + 15); \
        if (_rmax <= -128 || _rmin >= 128) { const float _t = _rmin >= 128 ? tbR : tbL; _Pragma("unroll") for (int _kt = 0; _kt < 4; ++_kt) tbv[_kt] = (f32x4){_t, _t, _t, _t}; } \
        else { _Pragma("unroll") for (int _kt = 0; _kt < 4; ++_kt) _Pragma("unroll") for (int _j = 0; _j < 4; ++_j) { int _ix = tixb + 256 * (jt) + (16 * _kt + _j) * 4; _ix = _ix < 0 ? 0 : (_ix > 1024 ? 1024 : _ix); tbv[_kt][_j] = *(const LAS float*)(tab + _ix); } } } while (0)
    AT_TB(tstart & tmask);
#pragma unroll
    for (int kt = 0; kt < 4; ++kt) {
#pragma unroll
        for (int c = 0; c < 2; ++c) {
            f32x4 a = tbv[kt];
#pragma unroll
            for (int kk = 0; kk < 2; ++kk) { const bf16x8 kf = *(const LAS bf16x8*)(lds + AT_K0 + kfo[c][kk] + kt * 4096); a = __builtin_amdgcn_mfma_f32_16x16x32_bf16(kf, qf[c][kk], a, 0, 0, 0); }
            s[c][kt] = a;
        }
    }
    AT_BAR(0);
    AT_STAGE(kg, kso, 3, AT_K0); AT_STAGE(vg, vso, 2, AT_V0 + 2 * AT_TILE);
    AT_TB((tstart + 1) & tmask);
    attn_step<true, false>(lds + AT_K0 + AT_TILE, 0u, kfo, vo, qf, s, pf, o, ol, tbv);
    AT_BAR(4);
    int k_i = AT_K0 + AT_TILE, k_n = AT_K0 + 2 * AT_TILE, k_p = AT_K0;
    for (int i = 1; i < NT - 1; ++i) {
        AT_STAGE(kg, kso, i + 3, k_i); AT_STAGE(vg, vso, i + 2, AT_V0 + ((i + 2) & 3) * AT_TILE);
        AT_TB((tstart + i + 1) & tmask);
        attn_step<true, true>(lds + k_n, lds0 + AT_V0 + ((i - 1) & 3) * AT_TILE, kfo, vo, qf, s, pf, o, ol, tbv);
        AT_BAR(4);
        { const int tmp = k_i; k_i = k_n; k_n = k_p; k_p = tmp; }
    }
    attn_step<false, true>(lds, lds0 + AT_V0 + ((NT - 2) & 3) * AT_TILE, kfo, vo, qf, s, pf, o, ol, tbv);
    attn_pv(lds0 + AT_V0 + ((NT - 1) & 3) * AT_TILE, vo, pf, o, ol);
#undef AT_STAGE
    const float i0 = 1.0f / ol[0][0], i1 = lam / ol[1][0];
    float ss = 0.f;
#pragma unroll
    for (int dt = 0; dt < 8; ++dt)
#pragma unroll
        for (int j = 0; j < 4; ++j) { const float v = o[0][dt][j] * i0 - o[1][dt][j] * i1; o[0][dt][j] = v; ss += v * v; }
    ss += __shfl_xor(ss, 16); ss += __shfl_xor(ss, 32);
    const float rs = __builtin_amdgcn_rsqf(ss * (1.0f / 128.0f) + EPS) * 0.8f;
    bf16_t* op = UQ + (size_t)(row0 + q0 + 16 * w + r16) * DM + 512 + 128 * h + 4 * fq;
#pragma unroll
    for (int dt = 0; dt < 8; ++dt) {
        const f32x4 gsl = *(const f32x4*)(subln + 16 * dt + 4 * fq);
        u32x2 wv; wv.x = cvtpk(o[0][dt][0] * rs * gsl[0], o[0][dt][1] * rs * gsl[1]); wv.y = cvtpk(o[0][dt][2] * rs * gsl[2], o[0][dt][3] * rs * gsl[3]);
        *(u32x2*)(op + 16 * dt) = wv;
    }
    AT_BAR(0);
#undef AT_BAR
#undef AT_TB
}

__device__ __forceinline__ s16x4 tr_read(const LAS unsigned char* p) { return __builtin_bit_cast(s16x4, __builtin_amdgcn_ds_read_tr16_b64_v4i16((LAS s16x4*)p)); }
constexpr int SG_P = 144, SG_TILE = 128 * SG_P;
__device__ __forceinline__ void sgu_unit(LAS unsigned char* lds, int x, bf16_t* UQ, const bf16_t* VA, const float* stv, const float* sgn, const bf16_t* SW, const float* sgb) {
    const int tid = threadIdx.x, lane = tid & 63, w = __builtin_amdgcn_readfirstlane(tid >> 6), r16 = lane & 15, fq = lane >> 4;
    const int chunk = x >> 1, half = x & 1, r0 = chunk * 128;
#pragma unroll
    for (int i = 0; i < 8; ++i) {
        const int id = tid + 512 * i, s = id >> 5, ch = id & 31, g2 = ch >> 3, d8 = ch & 7;
        const u32x4 v = *(const u32x4*)(VA + (size_t)(r0 + s) * 512 + 256 * half + 8 * ch);
        const float rs = rstd_from(stv, r0 + s, 8, 1.0f / 512.0f);
        const f32x4 g0 = *(const f32x4*)(sgn + 256 * half + 8 * ch), g1 = *(const f32x4*)(sgn + 256 * half + 8 * ch + 4);
        u32x4 o; o.x = cvtpk(bflo(v.x) * rs * g0[0], bfhi(v.x) * rs * g0[1]); o.y = cvtpk(bflo(v.y) * rs * g0[2], bfhi(v.y) * rs * g0[3]);
        o.z = cvtpk(bflo(v.z) * rs * g1[0], bfhi(v.z) * rs * g1[1]); o.w = cvtpk(bflo(v.w) * rs * g1[2], bfhi(v.w) * rs * g1[3]);
        *(LAS u32x4*)(lds + g2 * SG_TILE + s * SG_P + d8 * 16) = o;
    }
    __syncthreads();
    const int g2 = w & 3, th = w >> 2, g = 4 * half + g2;
    const LAS unsigned char* tb = lds + g2 * SG_TILE + (4 * fq + (r16 >> 2)) * SG_P + (r16 & 3) * 8;
    bf16x8 af[4][4];
#pragma unroll
    for (int dt = 0; dt < 4; ++dt)
#pragma unroll
        for (int ks = 0; ks < 4; ++ks) { const s16x4 lo = tr_read(tb + (32 * ks) * SG_P + dt * 32), hi = tr_read(tb + (32 * ks + 16) * SG_P + dt * 32);
            af[dt][ks] = (bf16x8){lo[0], lo[1], lo[2], lo[3], hi[0], hi[1], hi[2], hi[3]}; }
#pragma unroll
    for (int tt = 0; tt < 4; ++tt) {
        const int t = 64 * th + 16 * tt + r16;
        bf16x8 bfr[4];
#pragma unroll
        for (int ks = 0; ks < 4; ++ks) bfr[ks] = *(const bf16x8*)(SW + ((size_t)(g * 128 + t) * 128 + 32 * ks + 8 * fq));
        const float bt = sgb[g * 128 + t];
        bf16_t* up = UQ + (size_t)(r0 + t) * DM + 64 * g + 4 * fq;
#pragma unroll
        for (int dt = 0; dt < 4; ++dt) {
            f32x4 a = (f32x4){0.f, 0.f, 0.f, 0.f};
#pragma unroll
            for (int ks = 0; ks < 4; ++ks) a = __builtin_amdgcn_mfma_f32_16x16x32_bf16(af[dt][ks], bfr[ks], a, 0, 0, 0);
            const u32x2 uv = *(const u32x2*)(up + 16 * dt);
            u32x2 wv; wv.x = cvtpk(bflo(uv.x) * (a[0] + bt), bfhi(uv.x) * (a[1] + bt)); wv.y = cvtpk(bflo(uv.y) * (a[2] + bt), bfhi(uv.y) * (a[3] + bt));
            *(u32x2*)(up + 16 * dt) = wv;
        }
    }
    __syncthreads();
}

#define XB_TMO      128
#define XB_XCNT(j)  (256  + 64 * (j))
#define XB_XSUB(j)  (1280 + 64 * (j))
#define XB_XGEN(j)  (2304 + 64 * (j))
#define XB_TOP      3328
#define XB_TOPGEN   3392
#define XCD_BAR_WORDS 3456
#define XB_SPIN_CAP (1u << 18)
__device__ __forceinline__ unsigned xb_ld(unsigned* p)              { return __hip_atomic_load(p, __ATOMIC_RELAXED, __HIP_MEMORY_SCOPE_AGENT); }
__device__ __forceinline__ unsigned xb_add(unsigned* p, unsigned v) { return __hip_atomic_fetch_add(p, v, __ATOMIC_RELAXED, __HIP_MEMORY_SCOPE_AGENT); }
__device__ __forceinline__ unsigned xb_xcc_id() { return (unsigned)__builtin_amdgcn_s_getreg((3 << 11) | 20) & 0xFu; }
#define XB_SPIN(cond, bar) do { unsigned _sp = 0; while (cond) { __builtin_amdgcn_s_sleep(1); \
    if ((++_sp & 255u) == 0u) { if (xb_ld(&(bar)[XB_TMO])) break; if (_sp > XB_SPIN_CAP) { atomicAdd(&(bar)[XB_TMO], 1u); break; } } } } while (0)
struct XcdBarrier { unsigned* bar; unsigned x; volatile LAS unsigned* st; };
__device__ __forceinline__ XcdBarrier xcd_barrier_post(unsigned* bar, volatile LAS unsigned* st) {
    XcdBarrier b; b.bar = bar; b.x = xb_xcc_id(); b.st = st;
    if (threadIdx.x == 0) (void)xb_add(&bar[XB_XCNT(b.x)], 1u);
    return b;
}
__device__ __forceinline__ void xcd_barrier_complete(unsigned* bar, unsigned x, unsigned& nloc, unsigned& nx) {
    const unsigned G = gridDim.x * gridDim.y * gridDim.z;
    unsigned sum, cnt, mine, sp = 0u;
    for (;;) {
        sum = 0u; cnt = 0u; mine = 0u;
#pragma unroll
        for (unsigned j = 0; j < 16; ++j) { const unsigned c = xb_ld(&bar[XB_XCNT(j)]); sum += c; cnt += (c > 0u) ? 1u : 0u; mine = (j == x) ? c : mine; }
        if (sum == G) break;
        __builtin_amdgcn_s_sleep(1);
        if ((++sp & 255u) == 0u) { if (xb_ld(&bar[XB_TMO])) break; if (sp > XB_SPIN_CAP) { atomicAdd(&bar[XB_TMO], 1u); break; } }
    }
    nloc = mine > 0u ? mine : 1u; nx = cnt > 0u ? cnt : 1u;
}
__device__ __forceinline__ void xcd_barrier(const XcdBarrier& b) {
    asm volatile("s_waitcnt vmcnt(0)" ::: "memory");
    __syncthreads();
    if (threadIdx.x == 0) {
        unsigned* bar = b.bar;
        __builtin_amdgcn_s_waitcnt(0);
        unsigned nloc = b.st[0], nx = b.st[1];
        if (nloc == 0u) { xcd_barrier_complete(bar, b.x, nloc, nx); b.st[0] = nloc; b.st[1] = nx; }
        const unsigned old = xb_add(&bar[XB_XSUB(b.x)], 1u);
        const unsigned gen = old / nloc;
        if (old + 1u == (gen + 1u) * nloc) {
            __builtin_amdgcn_fence(__ATOMIC_RELEASE, "agent");
            asm volatile("s_waitcnt vmcnt(0)" ::: "memory");
            const unsigned og = xb_add(&bar[XB_TOP], 1u);
            const unsigned tg = og / nx;
            if (og + 1u == (tg + 1u) * nx) xb_add(&bar[XB_TOPGEN], 1u);
            else XB_SPIN(xb_ld(&bar[XB_TOPGEN]) == tg, bar);
            __builtin_amdgcn_fence(__ATOMIC_ACQUIRE, "agent");
            xb_add(&bar[XB_XGEN(b.x)], 1u);
            asm volatile("s_waitcnt vmcnt(0)" ::: "memory");
        } else {
            XB_SPIN(xb_ld(&bar[XB_XGEN(b.x)]) == gen, bar);
            __builtin_amdgcn_fence(__ATOMIC_ACQUIRE, "agent");
            asm volatile("s_waitcnt vmcnt(0)" ::: "memory");
        }
    }
    __syncthreads();
}

constexpr int N_PHASES = 11;
__global__ void __launch_bounds__(512, 2) fwd_megakernel(Params P) {
    extern __shared__ __attribute__((aligned(16))) unsigned char lds_raw[];
    LAS unsigned char* lds = (LAS unsigned char*)lds_raw;
    cg::grid_group grid = cg::this_grid();
    const int tid = threadIdx.x, lane = tid & 63, wave = __builtin_amdgcn_readfirstlane(tid >> 6);
    const int G = gridDim.x, bx = blockIdx.x, vcu = (G % 8 == 0) ? (bx % 8) * (G / 8) + bx / 8 : bx;
    unsigned char* ws = P.ws;
    const int lo = P.ph_lo, hi = P.ph_hi;
#define IN(k) (lo <= (k) && (k) < hi)
#define SEAM(k) do { if (IN(k) && IN((k) + 1)) { if (hi == 0x7fffffff) grid.sync(); else xcd_barrier(bar); } } while (0)
    volatile LAS unsigned* MISC = (volatile LAS unsigned*)(lds + MISC_OFF);
    if (tid < 16) MISC[tid] = 0u;
    __syncthreads();
    XcdBarrier bar; bar.bar = (unsigned*)(ws + WS_CTL); bar.x = 0; bar.st = MISC + 8;
    if (hi - lo > 1) bar = xcd_barrier_post((unsigned*)(ws + WS_CTL), MISC + 8);
    float* STA = (float*)(ws + WS_STA); float* STV = (float*)(ws + WS_STV);
    bf16_t* XB = (bf16_t*)(ws + WS_XB); bf16_t* UQ = (bf16_t*)(ws + WS_UQ); bf16_t* ACT = (bf16_t*)(ws + WS_ACT);

    if (IN(0)) { prologue(P, lds, vcu * 8 + wave, G * 8, wave, lane); }
    SEAM(0);
    if (IN(1)) {
        pg8::Gemm g{XB, (const bf16_t*)(ws + WS_W1IN), MT, 2 * DFF, DM}; pg8::StaticOrder S; S.init(MT, 2 * DFF, G, bx);
        EpiSwiGLU E{ACT, STA}; pg8::gemm_phase(lds, g, S, E);
    }
    SEAM(1);
    if (IN(2)) {
        pg8::Gemm g{ACT, (const bf16_t*)(ws + WS_W1OUT), MT, DM, DFF}; pg8::StaticOrder S; S.init(MT, DM, G, bx);
        EpiRes<true, false> E{nullptr, nullptr, XB, nullptr, XB, STA, 0.5f}; pg8::gemm_phase(lds, g, S, E);
    }
    SEAM(2);
    if (IN(3)) {
        pg8::Gemm g{XB, (const bf16_t*)(ws + WS_WIN), MT, NA1, DM}; pg8::StaticOrder S; S.init(MT, NA1, G, bx);
        EpiMixA E{UQ, (bf16_t*)(ws + WS_VA), (bf16_t*)(ws + WS_KB), (bf16_t*)(ws + WS_VB), STA, STV, P.in[12], P.in[13]}; pg8::gemm_phase(lds, g, S, E);
    }
    SEAM(3);
    if (IN(4)) {
        const float d1 = wave_sum(P.in[14][lane] * P.in[15][lane]), d2 = wave_sum(P.in[16][lane] * P.in[17][lane]);
        const float lam = expf(d1) - expf(d2) + 0.2f;
        float mq = fabsf(P.in[12][lane]), mk = fabsf(P.in[13][lane]), mb = fmaxf(P.in[2][lane], P.in[2][64 + lane]);
#pragma unroll
        for (int o = 1; o < 64; o <<= 1) { mq = fmaxf(mq, __shfl_xor(mq, o)); mk = fmaxf(mk, __shfl_xor(mk, o)); mb = fmaxf(mb, __shfl_xor(mb, o)); }
        const float bmax = 8.0f * mq * mk + mb;
        const bf16_t* KB = (const bf16_t*)(ws + WS_KB); const bf16_t* VB = (const bf16_t*)(ws + WS_VB);
        for (int i = vcu; i < NSEQ_S * 4 * 32; i += G) { const int sh = i >> 5, qb = i & 31; attn_unit(lds, NSEQ_P + (sh >> 2), sh & 3, qb, UQ, KB, VB, P.in[2], P.in[18], lam, bmax); }
        for (int i = vcu; i < NSEQ_P * 4 * 16; i += G) { const int sh = i >> 4, qb = i & 15; attn_unit(lds, sh >> 2, sh & 3, qb, UQ, KB, VB, P.in[2], P.in[18], lam, bmax); }
        for (int x = vcu; x < (MT / 128) * 2; x += G) sgu_unit(lds, x, UQ, (const bf16_t*)(ws + WS_VA), STV, P.in[9], (const bf16_t*)(ws + WS_SGUW), P.in[11]);
    }
    SEAM(4);
    if (IN(5)) {
        pg8::Gemm g{XB, (const bf16_t*)(ws + WS_WIN) + (size_t)NA1 * DM, MT, NG, DM}; pg8::StaticOrder S; S.init(MT, NG, G, bx);
        EpiGate E{(bf16_t*)(ws + WS_GA), (bf16_t*)(ws + WS_GB), STA, P.in[8]}; pg8::gemm_phase(lds, g, S, E);
    }
    SEAM(5);
    if (IN(6)) {
        pg8::Gemm g{UQ, (const bf16_t*)(ws + WS_WP), MT, DM, DM}; pg8::StaticOrder S; S.init(MT, DM, G, bx);
        EpiMerge E{(const bf16_t*)(ws + WS_GA), (const bf16_t*)(ws + WS_GB), (bf16_t*)(ws + WS_MG)}; pg8::gemm_phase(lds, g, S, E);
    }
    SEAM(6);
    if (IN(7)) {
        pg8::Gemm g{(const bf16_t*)(ws + WS_MG), (const bf16_t*)(ws + WS_WO), MT, DM, DM}; pg8::StaticOrder S; S.init(MT, DM, G, bx);
        EpiRes<true, false> E{nullptr, nullptr, XB, nullptr, (bf16_t*)(ws + WS_XB2), STA, 1.0f}; pg8::gemm_phase(lds, g, S, E);
    }
    SEAM(7);
    if (IN(8)) {
        pg8::Gemm g{(const bf16_t*)(ws + WS_XB2), (const bf16_t*)(ws + WS_W2IN), MT, 2 * DFF, DM}; pg8::StaticOrder S; S.init(MT, 2 * DFF, G, bx);
        EpiSwiGLU E{ACT, STA}; pg8::gemm_phase(lds, g, S, E);
    }
    SEAM(8);
    if (IN(9)) {
        pg8::Gemm g{ACT, (const bf16_t*)(ws + WS_W2OUT), MT, DM, DFF}; pg8::StaticOrder S; S.init(MT, DM, G, bx);
        EpiRes<true, false> E{nullptr, nullptr, (const bf16_t*)(ws + WS_XB2), nullptr, XB, STA, 0.5f}; pg8::gemm_phase(lds, g, S, E);
    }
    SEAM(9);
    if (IN(10)) {
        const float* fn = P.in[25];
        f32x4 gv[4];
#pragma unroll
        for (int j = 0; j < 4; ++j) gv[j] = ((const f32x4*)fn)[lane + 64 * j];
        for (int m = vcu * 8 + wave; m < MT; m += G * 16) {
            const int m1 = m + G * 8; const bool has1 = m1 < MT; const int mb = has1 ? m1 : m;
            const float rs0 = rstd_from(STA, m, 16, 1.0f / 1024.0f), rs1 = rstd_from(STA, mb, 16, 1.0f / 1024.0f);
            const u32x2* s0 = (const u32x2*)(XB + (size_t)m * DM) + lane; const u32x2* s1 = (const u32x2*)(XB + (size_t)mb * DM) + lane;
            u32x2 v0[4], v1[4];
#pragma unroll
            for (int j = 0; j < 4; ++j) { v0[j] = s0[64 * j]; v1[j] = s1[64 * j]; }
            f32x4* x40 = (f32x4*)(P.out + (size_t)m * DM) + lane; f32x4* x41 = (f32x4*)(P.out + (size_t)mb * DM) + lane;
#pragma unroll
            for (int j = 0; j < 4; ++j) x40[64 * j] = (f32x4){bflo(v0[j].x), bfhi(v0[j].x), bflo(v0[j].y), bfhi(v0[j].y)} * gv[j] * rs0;
            if (has1) {
#pragma unroll
                for (int j = 0; j < 4; ++j) x41[64 * j] = (f32x4){bflo(v1[j].x), bfhi(v1[j].x), bflo(v1[j].y), bfhi(v1[j].y)} * gv[j] * rs1;
            }
        }
    }
#undef IN
#undef SEAM
}

#ifndef MK_SPLIT
#define MK_SPLIT 0
#endif
extern "C" void kernel_launch(void* const* d_in, const int* in_sizes, int n_in, void* d_out, int out_size, void* d_ws, size_t ws_size, hipStream_t stream) {
    static int grid = 0;
    if (grid == 0) {
        if (n_in != 26 || out_size != MT * DM || ws_size < WS_CTL + CTL_BYTES) { fprintf(stderr, "kernel_launch: unexpected shapes: n_in %d out %d ws %zu (need %zu)\n", n_in, out_size, ws_size, (size_t)WS_END); grid = -1; return; }
        int dev = 0, cus = 0, per_cu = 0;
        hipGetDevice(&dev); hipDeviceGetAttribute(&cus, hipDeviceAttributeMultiprocessorCount, dev);
        if (hipFuncSetAttribute((const void*)fwd_megakernel, hipFuncAttributeMaxDynamicSharedMemorySize, LDS_BYTES) != hipSuccess) { fprintf(stderr, "kernel_launch: hipFuncSetAttribute failed\n"); grid = -1; return; }
        if (hipOccupancyMaxActiveBlocksPerMultiprocessor(&per_cu, (const void*)fwd_megakernel, 512, LDS_BYTES) != hipSuccess || per_cu < 1) { fprintf(stderr, "kernel_launch: occupancy query says %d\n", per_cu); per_cu = 1; }
        (void)hipGetLastError();
        grid = cus * 1;
    }
    if (grid < 0) return;
    Params p{};
    for (int i = 0; i < 26; ++i) p.in[i] = (const float*)d_in[i];
    p.out = (float*)d_out; p.ws = (unsigned char*)d_ws;
#if MK_SPLIT
    for (int k = 0; k < N_PHASES; ++k) { p.ph_lo = k; p.ph_hi = k + 1; hipLaunchKernelGGL(fwd_megakernel, dim3(grid), dim3(512), LDS_BYTES, stream, p); }
#else
    p.ph_lo = 0; p.ph_hi = N_PHASES;
    if (hipMemsetAsync((char*)d_ws + WS_CTL, 0, CTL_BYTES, stream) != hipSuccess) { fprintf(stderr, "kernel_launch: memset of the barrier words failed\n"); return; }
    void* args[] = {&p};
    hipError_t e = hipLaunchCooperativeKernel((const void*)fwd_megakernel, dim3(grid), dim3(512), args, LDS_BYTES, stream);
    if (e != hipSuccess) fprintf(stderr, "kernel_launch: cooperative launch failed: %s (grid %d)\n", hipGetErrorString(e), grid);
#endif
}
```
